# Optimizing an MI355X kernel written in HIP

```python
import math
import jax, jax.numpy as jnp
from jax import lax
import numpy as np

D_MODEL = 1024
BATCH = 4
SEQ = 8192
DEPTH = 2
DEC_BATCH = 32
DEC_SEQ = 2048
PAST_LEN = 128

GRID_W = 64
HEAD_DIM = 64
N_HEADS = 8
N_KV = 2
Q_BLOCK = 128
ROPE_THETA = 10000.0
AXIS_DIM = HEAD_DIM // 2
N_FREQ = AXIS_DIM // 2
H_RET = 4
RET_DK = 64
RET_DV = 128
RET_CHUNK = 128
D_FF = 2816
CONV_W = 3
EPS = 1e-6

W_QA = N_HEADS * HEAD_DIM
W_KA = N_KV * HEAD_DIM
W_VA = N_KV * HEAD_DIM
W_QR = H_RET * RET_DK
W_KR = H_RET * RET_DK
W_VR = H_RET * RET_DV
W_GR = H_RET * RET_DV
W_GATE = 2 * D_MODEL
IN_COLS = W_QA + W_KA + W_VA + W_QR + W_KR + W_VR + W_GR + W_GATE
SPLITS = [W_QA,
          W_QA + W_KA,
          W_QA + W_KA + W_VA,
          W_QA + W_KA + W_VA + W_QR,
          W_QA + W_KA + W_VA + W_QR + W_KR,
          W_QA + W_KA + W_VA + W_QR + W_KR + W_VR,
          W_QA + W_KA + W_VA + W_QR + W_KR + W_VR + W_GR]

kernel_name = "hybrid_gqa_retention_convffn_encoder"


def rms_norm(x, g):
    xf = x.astype(jnp.float32)
    y = xf * lax.rsqrt(jnp.mean(xf * xf, axis=-1, keepdims=True) + EPS)
    return (y * g.astype(jnp.float32)).astype(x.dtype)


def axial_rope_tables(n_tokens):
    rows = n_tokens // GRID_W
    row = jnp.repeat(jnp.arange(rows, dtype=jnp.float32), GRID_W)
    col = jnp.tile(jnp.arange(GRID_W, dtype=jnp.float32), rows)
    freqs = 1.0 / (ROPE_THETA ** (jnp.arange(N_FREQ, dtype=jnp.float32) / N_FREQ))
    ang = jnp.stack([row[:, None] * freqs, col[:, None] * freqs], axis=1)
    return jnp.cos(ang), jnp.sin(ang)


def apply_rope(x, cos, sin):
    shp = x.shape
    xs = x.reshape(shp[:-1] + (2, 2, N_FREQ))
    x1 = xs[..., 0, :]
    x2 = xs[..., 1, :]
    c = cos[:, None].astype(x.dtype)
    s = sin[:, None].astype(x.dtype)
    out = jnp.stack([x1 * c - x2 * s, x2 * c + x1 * s], axis=-2)
    return out.reshape(shp)


def gqa_blocked(q, k, v):
    B, S, H, dh = q.shape
    G = H // N_KV
    nb = S // Q_BLOCK
    qb = q.reshape(B, nb, Q_BLOCK, N_KV, G, dh).transpose(1, 0, 3, 4, 2, 5)
    kt = k.transpose(0, 2, 1, 3)
    vt = v.transpose(0, 2, 1, 3)
    scale = 1.0 / math.sqrt(dh)

    def one_block(qblk):
        s = jnp.einsum('bkgqd,bksd->bkgqs', qblk, kt).astype(jnp.float32) * scale
        p = jax.nn.softmax(s, axis=-1).astype(vt.dtype)
        return jnp.einsum('bkgqs,bksd->bkgqd', p, vt)

    o = lax.map(one_block, qb)
    return o.transpose(1, 0, 4, 2, 3, 5).reshape(B, S, H * dh)


def retention_dir(q, k, v, log_g, strict):
    B, H, S, dk = q.shape
    dv = v.shape[-1]
    nc = S // RET_CHUNK
    C = RET_CHUNK
    qc = q.reshape(B, H, nc, C, dk)
    kc = k.reshape(B, H, nc, C, dk)
    vc = v.reshape(B, H, nc, C, dv)
    pos = jnp.arange(C, dtype=jnp.float32)
    diff = pos[:, None] - pos[None, :]
    mask = (diff > 0) if strict else (diff >= 0)
    dmat = jnp.where(mask, jnp.exp(log_g[:, None, None] * jnp.maximum(diff, 0.0)), 0.0)
    s = jnp.einsum('bhncd,bhnmd->bhncm', qc, kc) * dmat[None, :, None]
    inner = jnp.einsum('bhncm,bhnme->bhnce', s, vc)
    kdec = jnp.exp(log_g[:, None] * (C - 1 - pos))
    kv = jnp.einsum('bhnmd,bhnme,hm->nbhde', kc, vc, kdec)
    chunk_decay = jnp.exp(log_g * C)[:, None, None]

    def step(R, kv_n):
        return chunk_decay * R + kv_n, R

    _, r_prev = lax.scan(step, jnp.zeros((B, H, dk, dv), jnp.float32), kv)
    qdec = jnp.exp(log_g[:, None] * (pos + 1.0))
    cross = jnp.einsum('bhncd,hc,nbhde->bhnce', qc, qdec, r_prev)
    return (inner + cross).reshape(B, H, S, dv)


def depthwise_conv3(u, w, b):
    up = jnp.pad(u, ((0, 0), (1, 1), (0, 0)))
    return up[:, :-2] * w[0] + up[:, 1:-1] * w[1] + up[:, 2:] * w[2] + b


def encoder_layer(x, cos, sin, norm1_g, w_in, q_norm_g, k_norm_g, dec_f, dec_b,
                  w_attn_o, w_ret_o, b_gate, w_out, norm2_g, w_up, conv_w, conv_b, w_down):
    B, S, _ = x.shape
    h = rms_norm(x, norm1_g)
    proj = h @ w_in
    qa, ka, va, qr, kr, vr, gr, gate_logits = jnp.split(proj, SPLITS, axis=-1)

    qa = apply_rope(rms_norm(qa.reshape(B, S, N_HEADS, HEAD_DIM), q_norm_g), cos, sin)
    ka = apply_rope(rms_norm(ka.reshape(B, S, N_KV, HEAD_DIM), k_norm_g), cos, sin)
    va = va.reshape(B, S, N_KV, HEAD_DIM)
    attn = gqa_blocked(qa, ka, va)
    attn_d = attn @ w_attn_o

    qr = apply_rope(qr.reshape(B, S, H_RET, RET_DK), cos, sin)
    kr = apply_rope(kr.reshape(B, S, H_RET, RET_DK), cos, sin) * (RET_DK ** -0.5)
    q_t = qr.transpose(0, 2, 1, 3).astype(jnp.float32)
    k_t = kr.transpose(0, 2, 1, 3).astype(jnp.float32)
    v_t = vr.reshape(B, S, H_RET, RET_DV).transpose(0, 2, 1, 3).astype(jnp.float32)
    lf = jax.nn.log_sigmoid(dec_f.astype(jnp.float32))
    lb = jax.nn.log_sigmoid(dec_b.astype(jnp.float32))
    y_f = retention_dir(q_t, k_t, v_t, lf, False)
    y_b = jnp.flip(retention_dir(jnp.flip(q_t, 2), jnp.flip(k_t, 2), jnp.flip(v_t, 2), lb, True), 2)
    y = y_f + y_b
    y = y * lax.rsqrt(jnp.mean(y * y, axis=-1, keepdims=True) + EPS)
    y = y.transpose(0, 2, 1, 3).reshape(B, S, W_VR).astype(x.dtype)
    ret_d = (jax.nn.silu(gr) * y) @ w_ret_o

    gates = jax.nn.sigmoid(gate_logits.astype(jnp.float32) + b_gate.astype(jnp.float32)).astype(x.dtype)
    g_a, g_r = jnp.split(gates, 2, axis=-1)
    x = x + (g_a * attn_d + g_r * ret_d) @ w_out

    h2 = rms_norm(x, norm2_g)
    u = depthwise_conv3(h2 @ w_up, conv_w, conv_b)
    val, gt = jnp.split(u, 2, axis=-1)
    x = x + (jax.nn.gelu(gt, approximate=False) * val) @ w_down
    return x


def setup_inputs(seed: int = 0) -> dict:
    key = jax.random.key(seed)
    ks = jax.random.split(key, 20)
    f32 = jnp.float32

    def nrm(k, shape, scale):
        return jax.random.normal(k, shape, f32) * scale

    base_logit = jnp.log(2.0 ** (5.0 + jnp.arange(H_RET, dtype=f32)) - 1.0)
    return {
        "x_prompt": nrm(ks[0], (BATCH, SEQ, D_MODEL), 1.0),
        "x_sample": nrm(ks[1], (DEC_BATCH, DEC_SEQ, D_MODEL), 1.0),
        "norm1_g": 1.0 + nrm(ks[2], (DEPTH, D_MODEL), 0.01),
        "w_in": nrm(ks[3], (DEPTH, D_MODEL, IN_COLS), D_MODEL ** -0.5),
        "q_norm_g": 1.0 + nrm(ks[4], (DEPTH, HEAD_DIM), 0.01),
        "k_norm_g": 1.0 + nrm(ks[5], (DEPTH, HEAD_DIM), 0.01),
        "ret_decay_fwd": base_logit[None] + nrm(ks[6], (DEPTH, H_RET), 0.1),
        "ret_decay_bwd": base_logit[None] + nrm(ks[7], (DEPTH, H_RET), 0.1),
        "w_attn_o": nrm(ks[8], (DEPTH, W_QA, D_MODEL), W_QA ** -0.5),
        "w_ret_o": nrm(ks[9], (DEPTH, W_VR, D_MODEL), W_VR ** -0.5),
        "b_gate": nrm(ks[10], (DEPTH, W_GATE), 0.1),
        "w_out": nrm(ks[11], (DEPTH, D_MODEL, D_MODEL), D_MODEL ** -0.5),
        "norm2_g": 1.0 + nrm(ks[12], (DEPTH, D_MODEL), 0.01),
        "w_up": nrm(ks[13], (DEPTH, D_MODEL, 2 * D_FF), D_MODEL ** -0.5),
        "conv_w": nrm(ks[14], (DEPTH, CONV_W, 2 * D_FF), CONV_W ** -0.5),
        "conv_b": nrm(ks[15], (DEPTH, 2 * D_FF), 0.01),
        "w_down": nrm(ks[16], (DEPTH, D_FF, D_MODEL), D_FF ** -0.5),
    }


def reference(x_prompt, x_sample, norm1_g, w_in, q_norm_g, k_norm_g, ret_decay_fwd, ret_decay_bwd,
              w_attn_o, w_ret_o, b_gate, w_out, norm2_g, w_up, conv_w, conv_b, w_down):
    cos_p, sin_p = axial_rope_tables(x_prompt.shape[1])
    cos_s, sin_s = axial_rope_tables(x_sample.shape[1])
    y_prompt = x_prompt
    y_sample = x_sample
    for l in range(DEPTH):
        params = (norm1_g[l], w_in[l], q_norm_g[l], k_norm_g[l], ret_decay_fwd[l], ret_decay_bwd[l],
                  w_attn_o[l], w_ret_o[l], b_gate[l], w_out[l], norm2_g[l], w_up[l], conv_w[l],
                  conv_b[l], w_down[l])
        y_prompt = encoder_layer(y_prompt, cos_p, sin_p, *params)
        y_sample = encoder_layer(y_sample, cos_s, sin_s, *params)
    return (y_prompt, y_sample)
```

```cpp
#include <hip/hip_runtime.h>
#include <hip/hip_cooperative_groups.h>
#include <cstdio>
#include <cstdint>
namespace cg = cooperative_groups;

#define EPS_F 1e-6f
__device__ __forceinline__ int ltid() { int t = threadIdx.x; asm volatile("" : "+v"(t)); return t; }
namespace pg8 {
#define PG8_LAS __attribute__((address_space(3)))
typedef unsigned short bf16_t;
typedef short bf16x8 __attribute__((ext_vector_type(8)));
typedef float f32x4 __attribute__((ext_vector_type(4)));
typedef unsigned u32x4 __attribute__((ext_vector_type(4)));
constexpr int BM = 256, BK = 64, HALF = 128, HTB = HALF * BK * 2  , STAGE_BYTES = 8 * HTB, NXCD = 8, WGM = 8;

__host__ __device__ __forceinline__ int lds_byte(int r, int c) { const int st = (r >> 4) * 2 + (c >> 5), rr = r & 15, cc = c & 31, ob = rr * 64 + cc * 2; return st * 1024 + (ob ^ (((ob >> 9) & 1) << 5)); }
__host__ __device__ __forceinline__ void stage_rc(int b, int& R, int& C) { const int st = b / 1024, sb = b % 1024, swz = sb ^ (((sb >> 9) & 1) << 5); R = (st >> 1) * 16 + swz / 64; C = (st & 1) * 32 + (swz % 64) / 2; }
__host__ __device__ __forceinline__ int perm32(int rho) { const int n = rho >> 4, i = rho & 15; return 8 * (i >> 2) + 4 * n + (i & 3); }

struct Unit { int pm, pn, koff, part, ord; };
struct Gemm { const bf16_t* A; const bf16_t* Bt; int M, N, K, ld; };

struct StaticOrder {
    int nM, nN, nwg, G, c;
    __host__ __device__ void init(int M, int N, int G_, int c_) { nM = M / BM; nN = N / BM; nwg = nM * nN; G = G_; c = c_; }
    __host__ __device__ bool next(int i, Unit& u) const {
        const long L = (long)i * G + c; if (L >= nwg) return false;
        int wgid = (int)L; { const int q = nwg / NXCD, r = nwg % NXCD, xcd = wgid % NXCD, off = wgid / NXCD; wgid = (xcd < r ? xcd * (q + 1) : r * (q + 1) + (xcd - r) * q) + off; }
        const int nig = WGM * nN, gid = wgid / nig, fm = gid * WGM, gsz = (nM - fm) < WGM ? (nM - fm) : WGM;
        u.pm = fm + ((wgid % nig) % gsz); u.pn = (wgid % nig) / gsz; u.koff = 0; u.part = 1; u.ord = i; return true;
    }
    __device__ __forceinline__ void a_ready(const Unit&) const {}
    __device__ __forceinline__ void done(const Unit&) const {}
};

struct PairOrder {
    StaticOrder so; int kpart;
    __host__ __device__ void init(int M, int N, int G_, int c_, int kpart_) { so.init(M, N, G_, c_); kpart = kpart_; }
    __host__ __device__ bool next(int i, Unit& u) const { if (!so.next(i >> 1, u)) return false; u.ord = i >> 1; u.part = i & 1; u.koff = (i & 1) * kpart; return true; }
    __device__ __forceinline__ void a_ready(const Unit&) const {}
    __device__ __forceinline__ void done(const Unit&) const {}
};
typedef unsigned u32x2 __attribute__((ext_vector_type(2)));
typedef float f32x2_t __attribute__((ext_vector_type(2))); typedef __bf16 bf16x2_t __attribute__((ext_vector_type(2)));
__device__ __forceinline__ unsigned cvt_pk_bf16(float lo, float hi) { f32x2_t v = {lo, hi}; bf16x2_t b = __builtin_convertvector(v, bf16x2_t); return __builtin_bit_cast(unsigned, b); }
__device__ __forceinline__ u32x2 pk4(f32x4 v) { u32x2 w; w.x = cvt_pk_bf16(v[0], v[1]); w.y = cvt_pk_bf16(v[2], v[3]); return w; }
__device__ __forceinline__ bf16_t bf1(float v) { return (bf16_t)(cvt_pk_bf16(v, v) & 0xffffu); }
__device__ __forceinline__ f32x4 unpk4(u32x2 w) { f32x4 v; v[0] = __uint_as_float(w.x << 16); v[1] = __uint_as_float(w.x & 0xffff0000u); v[2] = __uint_as_float(w.y << 16); v[3] = __uint_as_float(w.y & 0xffff0000u); return v; }
__device__ __forceinline__ float row_rstd(const float* ss, int t) {
    const f32x4* sp = (const f32x4*)(ss + (size_t)t * 16);
    const f32x4 a0 = sp[0], a1 = sp[1], a2 = sp[2], a3 = sp[3];
    const float tot = (((a0[0] + a0[1]) + (a0[2] + a0[3])) + ((a1[0] + a1[1]) + (a1[2] + a1[3]))) + (((a2[0] + a2[1]) + (a2[2] + a2[3])) + ((a3[0] + a3[1]) + (a3[2] + a3[3])));
    return rsqrtf(tot * (1.0f / 1024.0f) + EPS_F);
}

typedef float f32x2 __attribute__((ext_vector_type(2)));
__device__ __forceinline__ f32x2 gelu_pk(f32x2 v) {
    const f32x2 av = __builtin_elementwise_abs(v), d = av * 0.2316418882f + 1.0f;
    f32x2 t; t.x = __builtin_amdgcn_rcpf(d.x); t.y = __builtin_amdgcn_rcpf(d.y);
    f32x2 q = t * 0.5307027145f + (-0.7265760135f); q = q * t + 0.7107068705f; q = q * t + (-0.142248368f); q = q * t + 0.127414796f; q = q * t;
    const f32x2 s = (v * v) * (-0.72134752044f);
    f32x2 e; e.x = __builtin_amdgcn_exp2f(s.x); e.y = __builtin_amdgcn_exp2f(s.y);
    const f32x2 m = v * (q * e), r = v - m;
    f32x2 o; o.x = v.x < 0.f ? m.x : r.x; o.y = v.y < 0.f ? m.y : r.y; return o;
}

typedef __attribute__((address_space(3))) const float lds_cf;
__device__ __forceinline__ void rows_rstd(lds_cf* rt, int ord, int wr, int fr, float (&rs)[2][4]) {
#pragma unroll
    for (int ai = 0; ai < 2; ++ai)
#pragma unroll
        for (int m = 0; m < 4; ++m) rs[ai][m] = rt[ord * BM + ai * HALF + wr * 64 + m * 16 + fr];
}
template <class Sched> __device__ __forceinline__ void rstd_table(const float* ss, const Sched& S, __attribute__((address_space(3))) float* rt) {
    const int tid = ltid(), half = tid >> 8, row = tid & 255;
    Unit u;
    for (int i = half; S.next(i, u); i += 2) {
        const f32x4* sp = (const f32x4*)(ss + (size_t)(u.pm * BM + row) * 16);
        const f32x4 s4 = (sp[0] + sp[1]) + (sp[2] + sp[3]);
        rt[i * BM + row] = rsqrtf(((s4[0] + s4[1]) + (s4[2] + s4[3])) * (1.0f / 1024.0f) + EPS_F);
    }
    __syncthreads();
}

struct EpiIn {
    static constexpr bool PERM = false, AFTER_DRAIN = false;
    lds_cf* rt; const float* gq; const float* gk; const float* bgate; const float* dec2;
    bf16_t *Qa, *Ka, *Vat, *Qr, *Kr, *Ktf, *Ktb, *Vrt, *Gr, *Gates;
    int S, sshift;
    __device__ __forceinline__ void operator()(const f32x4 (&acc)[2][2][4][2], const Unit& u, int wr, int wc, int fr, int fq) const {
        asm volatile("" : "+v"(fr), "+v"(fq));
        const int pn = u.pn;
        const int t00 = u.pm * BM + wr * 64 + fr;
        float rs[2][4];
        rows_rstd(rt, u.ord, wr, fr, rs);
        float lf2 = 0.f, lb2 = 0.f;
        f32x4 g4[2][2], b4[2][2];
        const bool do_norm = (pn <= 1) || (pn == 2 && wc < 2);
        if (pn == 4) { lf2 = dec2[wc]; lb2 = dec2[4 + wc]; }
        if (do_norm) { const float* gg = (pn <= 1) ? gq : gk;
#pragma unroll
            for (int bj = 0; bj < 2; ++bj)
#pragma unroll
                for (int n = 0; n < 2; ++n) g4[bj][n] = *(const f32x4*)(gg + 32 * bj + 16 * n + 4 * fq); }
        if (pn >= 9) {
#pragma unroll
            for (int bj = 0; bj < 2; ++bj)
#pragma unroll
                for (int n = 0; n < 2; ++n) b4[bj][n] = *(const f32x4*)(bgate + 256 * (pn - 9) + 32 * wc + 4 * fq + 128 * bj + 16 * n); }
        f32x4 frev;
#pragma unroll
        for (int e = 0; e < 4; ++e) frev[e] = __builtin_amdgcn_exp2f(-(float)(4 * fq + e) * 0.8304820237218406f) * 0.15915494309189535f;
#pragma unroll
        for (int ai = 0; ai < 2; ++ai)
#pragma unroll
            for (int m = 0; m < 4; ++m) {
                const int t = t00 + ai * HALF + m * 16;
                const float rstd = rs[ai][m];
                f32x4 v[2][2];
#pragma unroll
                for (int bj = 0; bj < 2; ++bj)
#pragma unroll
                    for (int n = 0; n < 2; ++n) v[bj][n] = acc[ai][bj][m][n] * rstd;
                const int s = t & (S - 1), seq = t >> sshift;
                if (pn <= 4) {
                    const bool isv = (pn == 2) && (wc >= 2);
                    if (do_norm) {
                        float q = 0.f;
#pragma unroll
                        for (int bj = 0; bj < 2; ++bj)
#pragma unroll
                            for (int n = 0; n < 2; ++n) { const f32x4 x = v[bj][n]; q += (x[0] * x[0] + x[1] * x[1]) + (x[2] * x[2] + x[3] * x[3]); }
                        q += __shfl_xor(q, 16); q += __shfl_xor(q, 32);
                        const float inv = rsqrtf(q * (1.0f / 64.0f) + EPS_F);
#pragma unroll
                        for (int bj = 0; bj < 2; ++bj)
#pragma unroll
                            for (int n = 0; n < 2; ++n) v[bj][n] = v[bj][n] * inv * g4[bj][n];
                    }
                    if (!isv) {
#pragma unroll
                        for (int bj = 0; bj < 2; ++bj) {
                            const float pos = (float)((bj == 0) ? (s >> 6) : (s & 63));
                            f32x4 c, sn;
#pragma unroll
                            for (int e = 0; e < 4; ++e) { float rev = pos * frev[e]; rev = rev - floorf(rev); c[e] = __builtin_amdgcn_cosf(rev); sn[e] = __builtin_amdgcn_sinf(rev); }
                            const f32x4 x1 = v[bj][0], x2 = v[bj][1];
                            v[bj][0] = x1 * c - x2 * sn; v[bj][1] = x2 * c + x1 * sn;
                        }
                    }
                    if (pn <= 1) {
                        bf16_t* dst = Qa + (size_t)t * 512 + (4 * pn + wc) * 64 + 4 * fq;
#pragma unroll
                        for (int bj = 0; bj < 2; ++bj)
#pragma unroll
                            for (int n = 0; n < 2; ++n) *(u32x2*)(dst + 32 * bj + 16 * n) = pk4(v[bj][n] * 0.18033688011112042f);
                    } else if (pn == 2) {
                        if (wc < 2) {
                            bf16_t* dst = Ka + (size_t)t * 128 + wc * 64 + 4 * fq;
#pragma unroll
                            for (int bj = 0; bj < 2; ++bj)
#pragma unroll
                                for (int n = 0; n < 2; ++n) *(u32x2*)(dst + 32 * bj + 16 * n) = pk4(v[bj][n]);
                        } else {
                            bf16_t* dst = Vat + ((size_t)(seq * 2 + (wc - 2)) * 64 + 4 * fq) * S + s;
#pragma unroll
                            for (int bj = 0; bj < 2; ++bj)
#pragma unroll
                                for (int n = 0; n < 2; ++n)
#pragma unroll
                                    for (int e = 0; e < 4; ++e) dst[(size_t)(32 * bj + 16 * n + e) * S] = bf1(v[bj][n][e]);
                        }
                    } else if (pn == 3) {
                        bf16_t* dst = Qr + (size_t)t * 256 + wc * 64 + 4 * fq;
#pragma unroll
                        for (int bj = 0; bj < 2; ++bj)
#pragma unroll
                            for (int n = 0; n < 2; ++n) *(u32x2*)(dst + 32 * bj + 16 * n) = pk4(v[bj][n]);
                    } else {
                        const int pc = s & 127;
                        const float df = __builtin_amdgcn_exp2f(lf2 * (float)(127 - pc)) * 0.125f, db = __builtin_amdgcn_exp2f(lb2 * (float)pc) * 0.125f;
                        bf16_t* dst = Kr + (size_t)t * 256 + wc * 64 + 4 * fq;
                        const size_t toff = ((size_t)(seq * 4 + wc) * 64 + 4 * fq) * S + s;
#pragma unroll
                        for (int bj = 0; bj < 2; ++bj)
#pragma unroll
                            for (int n = 0; n < 2; ++n) {
                                *(u32x2*)(dst + 32 * bj + 16 * n) = pk4(v[bj][n] * 0.125f);
#pragma unroll
                                for (int e = 0; e < 4; ++e) { const size_t o = toff + (size_t)(32 * bj + 16 * n + e) * S; Ktf[o] = bf1(v[bj][n][e] * df); Ktb[o] = bf1(v[bj][n][e] * db); }
                            }
                    }
                } else if (pn <= 6) {
#pragma unroll
                    for (int bj = 0; bj < 2; ++bj) {
                        bf16_t* dst = Vrt + ((size_t)(seq * 4 + 2 * (pn - 5) + bj) * 128 + 32 * wc + 4 * fq) * S + s;
#pragma unroll
                        for (int n = 0; n < 2; ++n)
#pragma unroll
                            for (int e = 0; e < 4; ++e) dst[(size_t)(16 * n + e) * S] = bf1(v[bj][n][e]);
                    }
                } else if (pn <= 8) {
                    bf16_t* dst = Gr + (size_t)t * 512 + 256 * (pn - 7) + 32 * wc + 4 * fq;
#pragma unroll
                    for (int bj = 0; bj < 2; ++bj)
#pragma unroll
                        for (int n = 0; n < 2; ++n) { f32x4 x = v[bj][n];
#pragma unroll
                            for (int e = 0; e < 4; ++e) x[e] = x[e] * __builtin_amdgcn_rcpf(1.0f + __builtin_amdgcn_exp2f(-1.4426950408889634f * x[e]));
                            *(u32x2*)(dst + 128 * bj + 16 * n) = pk4(x); }
                } else {
                    bf16_t* dst = Gates + (size_t)t * 2048 + 256 * (pn - 9) + 32 * wc + 4 * fq;
#pragma unroll
                    for (int bj = 0; bj < 2; ++bj)
#pragma unroll
                        for (int n = 0; n < 2; ++n) { f32x4 x = v[bj][n] + b4[bj][n];
#pragma unroll
                            for (int e = 0; e < 4; ++e) x[e] = __builtin_amdgcn_rcpf(1.0f + __builtin_amdgcn_exp2f(-1.4426950408889634f * x[e]));
                            *(u32x2*)(dst + 128 * bj + 16 * n) = pk4(x); }
                }
            }
    }
};

struct EpiMergeF {
    static constexpr bool PERM = false, AFTER_DRAIN = false;
    const bf16_t* Gates; bf16_t* Mg;
    __device__ __forceinline__ void operator()(f32x4 (&acc)[2][2][4][2], const Unit& u, int wr, int wc, int fr, int fq) const {
        asm volatile("" : "+v"(fr), "+v"(fq));
        const int t00 = u.pm * BM + wr * 64 + fr, c0 = u.pn * BM + 32 * wc + 4 * fq;
        if (u.part == 0) {
#pragma unroll
            for (int ai = 0; ai < 2; ++ai) {
                u32x2 ga[4][2][2], gr[4][2][2];
#pragma unroll
                for (int m = 0; m < 4; ++m)
#pragma unroll
                    for (int bj = 0; bj < 2; ++bj)
#pragma unroll
                        for (int n = 0; n < 2; ++n) { const bf16_t* gp = Gates + (size_t)(t00 + ai * HALF + m * 16) * 2048 + c0 + 128 * bj + 16 * n; ga[m][bj][n] = *(const u32x2*)gp; gr[m][bj][n] = *(const u32x2*)(gp + 1024); }
#pragma unroll
                for (int m = 0; m < 4; ++m)
#pragma unroll
                    for (int bj = 0; bj < 2; ++bj)
#pragma unroll
                        for (int n = 0; n < 2; ++n) { const f32x4 a4 = unpk4(ga[m][bj][n]), r4 = unpk4(gr[m][bj][n]); f32x4 r = acc[ai][bj][m][n];
#pragma unroll
                            for (int e = 0; e < 4; ++e) r[e] *= a4[e] * __builtin_amdgcn_rcpf(r4[e]);
                            acc[ai][bj][m][n] = r; }
            }
        } else {
            u32x2 gr[2][4][2][2];
#pragma unroll
            for (int ai = 0; ai < 2; ++ai)
#pragma unroll
                for (int m = 0; m < 4; ++m)
#pragma unroll
                    for (int bj = 0; bj < 2; ++bj)
#pragma unroll
                        for (int n = 0; n < 2; ++n) gr[ai][m][bj][n] = *(const u32x2*)(Gates + (size_t)(t00 + ai * HALF + m * 16) * 2048 + 1024 + c0 + 128 * bj + 16 * n);
#pragma unroll
            for (int ai = 0; ai < 2; ++ai)
#pragma unroll
                for (int m = 0; m < 4; ++m)
#pragma unroll
                    for (int bj = 0; bj < 2; ++bj)
#pragma unroll
                        for (int n = 0; n < 2; ++n) *(u32x2*)(Mg + (size_t)(t00 + ai * HALF + m * 16) * 1024 + c0 + 128 * bj + 16 * n) = pk4(acc[ai][bj][m][n] * unpk4(gr[ai][m][bj][n]));
        }
    }
};

template <bool FINAL> struct EpiResid {
    static constexpr bool PERM = false, AFTER_DRAIN = false;
    bf16_t* xb; float* out; float* ss;
    __device__ __forceinline__ void operator()(f32x4 (&acc)[2][2][4][2], const Unit& u, int wr, int wc, int fr, int fq) const {
        asm volatile("" : "+v"(fr), "+v"(fq));
        const int t00 = u.pm * BM + wr * 64 + fr, c0 = u.pn * BM + 32 * wc + 4 * fq;
        u32x2 xo[4][2][2];
#define RES_LOAD(ai) _Pragma("unroll") for (int m = 0; m < 4; ++m) _Pragma("unroll") for (int bj = 0; bj < 2; ++bj) _Pragma("unroll") for (int n = 0; n < 2; ++n) \
            xo[m][bj][n] = *(const u32x2*)(xb + (size_t)(t00 + (ai) * HALF + m * 16) * 1024 + c0 + 128 * bj + 16 * n);
#define RES_ADD(ai) _Pragma("unroll") for (int m = 0; m < 4; ++m) _Pragma("unroll") for (int bj = 0; bj < 2; ++bj) _Pragma("unroll") for (int n = 0; n < 2; ++n) acc[ai][bj][m][n] += unpk4(xo[m][bj][n]);
#define RES_STORE(ai) _Pragma("unroll") for (int m = 0; m < 4; ++m) { const int t = t00 + (ai) * HALF + m * 16; float q = 0.f; \
            _Pragma("unroll") for (int bj = 0; bj < 2; ++bj) _Pragma("unroll") for (int n = 0; n < 2; ++n) { const size_t o = (size_t)t * 1024 + c0 + 128 * bj + 16 * n; const f32x4 x = acc[ai][bj][m][n]; \
                if (FINAL) *(f32x4*)(out + o) = x; else { *(u32x2*)(xb + o) = pk4(x); q += (x[0] * x[0] + x[1] * x[1]) + (x[2] * x[2] + x[3] * x[3]); } } \
            if (!FINAL) { q += __shfl_xor(q, 16); q += __shfl_xor(q, 32); if (fq == 0) ss[(size_t)t * 16 + u.pn * 4 + wc] = q; } }
        RES_LOAD(0) RES_ADD(0) RES_LOAD(1) RES_STORE(0) RES_ADD(1) RES_STORE(1)
#undef RES_LOAD
#undef RES_ADD
#undef RES_STORE
    }
};

template <int CTRL> __device__ __forceinline__ float dpp_f(float v) { int iv = __builtin_bit_cast(int, v); asm volatile("" : "+v"(iv)); int r = __builtin_amdgcn_update_dpp(0, iv, CTRL, 0xF, 0xF, false); asm volatile("" : "+v"(r)); return __builtin_bit_cast(float, r); }
__device__ __forceinline__ f32x4 dpp_ror1(f32x4 v) { f32x4 r; r[0] = dpp_f<0x121>(v[0]); r[1] = dpp_f<0x121>(v[1]); r[2] = dpp_f<0x121>(v[2]); r[3] = dpp_f<0x121>(v[3]); return r; }
__device__ __forceinline__ f32x4 dpp_ror15(f32x4 v) { f32x4 r; r[0] = dpp_f<0x12F>(v[0]); r[1] = dpp_f<0x12F>(v[1]); r[2] = dpp_f<0x12F>(v[2]); r[3] = dpp_f<0x12F>(v[3]); return r; }
typedef __attribute__((address_space(3))) float lds_f;
struct EpiUpConv {
    static constexpr bool PERM = false, AFTER_DRAIN = false;
    lds_cf* rt; lds_f* xch; const float* cw; const float* cb; bf16_t* ACT; bf16_t* Uedge;
    __device__ __forceinline__ void operator()(f32x4 (&acc)[2][2][4][2], const Unit& u, int wr, int wc, int fr, int fq) const {
        asm volatile("" : "+v"(fr), "+v"(fq));
        float rs[2][4];
        rows_rstd(rt, u.ord, wr, fr, rs);
#pragma unroll
        for (int ai = 0; ai < 2; ++ai)
#pragma unroll
            for (int bj = 0; bj < 2; ++bj)
#pragma unroll
                for (int m = 0; m < 4; ++m)
#pragma unroll
                    for (int n = 0; n < 2; ++n) acc[ai][bj][m][n] *= rs[ai][m];
        lds_f* xb_ = xch + (u.ord & 1) * 2048 + wc * 512;
        if (fr == 0) {
#pragma unroll
            for (int ai = 0; ai < 2; ++ai)
#pragma unroll
                for (int bj = 0; bj < 2; ++bj)
#pragma unroll
                    for (int n = 0; n < 2; ++n) *(__attribute__((address_space(3))) f32x4*)(xb_ + ((2 * ai + wr) * 2 + 0) * 64 + (bj * 2 + n) * 16 + fq * 4) = acc[ai][bj][0][n];
        }
        if (fr == 15) {
#pragma unroll
            for (int ai = 0; ai < 2; ++ai)
#pragma unroll
                for (int bj = 0; bj < 2; ++bj)
#pragma unroll
                    for (int n = 0; n < 2; ++n) *(__attribute__((address_space(3))) f32x4*)(xb_ + ((2 * ai + wr) * 2 + 1) * 64 + (bj * 2 + n) * 16 + fq * 4) = acc[ai][bj][3][n];
        }
        if (wr == 0 && fr < 2) {
            bf16_t* dst = Uedge + ((size_t)u.pm * 4 + fr) * 5632 + u.pn * BM + 32 * wc + 4 * fq;
#pragma unroll
            for (int bj = 0; bj < 2; ++bj)
#pragma unroll
                for (int n = 0; n < 2; ++n) *(u32x2*)(dst + 128 * bj + 16 * n) = pk4(acc[0][bj][0][n]);
        }
        if (wr == 1 && fr >= 14) {
            bf16_t* dst = Uedge + ((size_t)u.pm * 4 + 2 + (fr - 14)) * 5632 + u.pn * BM + 32 * wc + 4 * fq;
#pragma unroll
            for (int bj = 0; bj < 2; ++bj)
#pragma unroll
                for (int n = 0; n < 2; ++n) *(u32x2*)(dst + 128 * bj + 16 * n) = pk4(acc[1][bj][3][n]);
        }
        asm volatile("s_waitcnt lgkmcnt(0)" ::: "memory"); __builtin_amdgcn_s_barrier(); asm volatile("" ::: "memory");
#pragma unroll
        for (int n = 0; n < 2; ++n) {
            const int v0 = u.pn * 128 + 32 * wc + 16 * n + 4 * fq;
            f32x4 w[2][3], bb[2];
#pragma unroll
            for (int bj = 0; bj < 2; ++bj) {
#pragma unroll
                for (int k = 0; k < 3; ++k) w[bj][k] = *(const f32x4*)(cw + k * 5632 + bj * 2816 + v0);
                bb[bj] = *(const f32x4*)(cb + bj * 2816 + v0);
            }
#pragma unroll
            for (int ai = 0; ai < 2; ++ai) {
                const int blk = 2 * ai + wr;
                f32x4 P[2], N[2];
#pragma unroll
                for (int bj = 0; bj < 2; ++bj) {
                    P[bj] = (blk > 0) ? *(const __attribute__((address_space(3))) f32x4*)(xb_ + ((blk - 1) * 2 + 1) * 64 + (bj * 2 + n) * 16 + fq * 4) : (f32x4){0.f, 0.f, 0.f, 0.f};
                    N[bj] = (blk < 3) ? *(const __attribute__((address_space(3))) f32x4*)(xb_ + ((blk + 1) * 2 + 0) * 64 + (bj * 2 + n) * 16 + fq * 4) : (f32x4){0.f, 0.f, 0.f, 0.f};
                }
#pragma unroll
                for (int m = 0; m < 4; ++m) {
                    f32x4 y[2];
#pragma unroll
                    for (int bj = 0; bj < 2; ++bj) {
                        const f32x4 x = acc[ai][bj][m][n];
                        const f32x4 rp = dpp_ror1(x), rn = dpp_ror15(x);
                        const f32x4 sp = (m > 0) ? dpp_ror1(acc[ai][bj][m > 0 ? m - 1 : 0][n]) : P[bj];
                        const f32x4 sn = (m < 3) ? dpp_ror15(acc[ai][bj][m < 3 ? m + 1 : 3][n]) : N[bj];
                        f32x4 pv, nv;
#pragma unroll
                        for (int e = 0; e < 4; ++e) { pv[e] = (fr == 0) ? sp[e] : rp[e]; nv[e] = (fr == 15) ? sn[e] : rn[e]; }
                        y[bj] = w[bj][0] * pv + w[bj][1] * x + w[bj][2] * nv + bb[bj];
                    }
                    const f32x2 g0 = gelu_pk((f32x2){y[1][0], y[1][1]}), g1 = gelu_pk((f32x2){y[1][2], y[1][3]});
                    const f32x4 o = {g0.x * y[0][0], g0.y * y[0][1], g1.x * y[0][2], g1.y * y[0][3]};
                    const int trow = ai * HALF + wr * 64 + m * 16 + fr;
                    if (trow != 0 && trow != 255) *(u32x2*)(ACT + (size_t)(u.pm * BM + trow) * 2816 + v0) = pk4(o);
                }
            }
        }
    }
};

template <class Epi, class Sched, bool ALIGN_EPI = false, bool SP2 = false>
__device__ __forceinline__ void gemm_phase(PG8_LAS unsigned char* lds, const Gemm g, const Sched& S, const Epi& E) {
    const int tid = ltid(), wid = __builtin_amdgcn_readfirstlane(tid >> 6), lane = tid & 63, wr = wid >> 2, wc = wid & 3, fr = lane & 15, fq = lane >> 4;
    const int K = g.K, LD = g.ld, nt = K / BK;
    unsigned voffA[2], voffB[2];
#pragma unroll
    for (int i = 0; i < 2; ++i) { int R, C; stage_rc(tid * 16 + i * 8192, R, C); const int Rb = Epi::PERM ? ((R & ~31) + perm32(R & 31)) : R;
        voffA[i] = (unsigned)(R * LD + C) * 2u; voffB[i] = (unsigned)(Rb * LD + C) * 2u; }
    const size_t kstep = (size_t)(BK * 2);
    const size_t hstep = (size_t)HALF * LD * 2;
    const size_t tstep = 2 * hstep;
    const unsigned ldsw = (unsigned)wid * 1024u;
    const int aoff = lds_byte(wr * 64 + fr, fq * 8), boff = lds_byte(wc * 32 + fr, fq * 8);
#define PG8_SA(b, h) (((b) * 2 + (h)) * HTB)
#define PG8_SB(b, h) ((4 + (b) * 2 + (h)) * HTB)
#define PG8_STAGE(bufoff, gbase, voff) do { _Pragma("unroll") for (int _i = 0; _i < 2; ++_i) \
        __builtin_amdgcn_global_load_lds((const unsigned*)((const char*)(gbase) + (voff)[_i]), (PG8_LAS unsigned*)(lds + (bufoff) + ldsw + _i * 8192), 16, 0, 0); } while (0)
#define PG8_LDA(dst, b, h) do { _Pragma("unroll") for (int m = 0; m < 4; ++m) _Pragma("unroll") for (int k = 0; k < 2; ++k) dst[m][k] = *(const PG8_LAS bf16x8*)(lds + PG8_SA(b, h) + aoff + m * 2048 + k * 1024); } while (0)
#define PG8_LDB(dst, b, h) do { _Pragma("unroll") for (int n = 0; n < 2; ++n) _Pragma("unroll") for (int k = 0; k < 2; ++k) dst[n][k] = *(const PG8_LAS bf16x8*)(lds + PG8_SB(b, h) + boff + n * 2048 + k * 1024); } while (0)
#define PG8_MMA(ai, bj, At, Bt) do { __builtin_amdgcn_s_setprio(1); _Pragma("unroll") for (int m = 0; m < 4; ++m) _Pragma("unroll") for (int n = 0; n < 2; ++n) _Pragma("unroll") for (int k = 0; k < 2; ++k) \
        acc[ai][bj][m][n] = __builtin_amdgcn_mfma_f32_16x16x32_bf16(Bt[n][k], At[m][k], acc[ai][bj][m][n], 0, 0, 0); __builtin_amdgcn_s_setprio(0); } while (0)
#define PG8_WAIT_V(n) asm volatile("s_waitcnt vmcnt(" #n ")" ::: "memory")
#define PG8_WAIT_L(n) asm volatile("s_waitcnt lgkmcnt(" #n ")" ::: "memory")
#define PG8_BAR __builtin_amdgcn_s_barrier()
#define PG8_SCHED __builtin_amdgcn_sched_barrier(0)
    Unit cur, nxt; int ui = 0;
    if (!S.next(0, cur)) return;
    f32x4 acc[2][2][4][2];
#pragma unroll
    for (int a = 0; a < 2; ++a)
#pragma unroll
        for (int b = 0; b < 2; ++b)
#pragma unroll
            for (int m = 0; m < 4; ++m)
#pragma unroll
                for (int n = 0; n < 2; ++n) acc[a][b][m][n] = (f32x4){0.f, 0.f, 0.f, 0.f};
    bf16x8 At[4][2], B0[2][2], B1[2][2];
    const char* cA = (const char*)g.A + (size_t)cur.pm * tstep + (size_t)cur.koff * 2; const char* cB = (const char*)g.Bt + (size_t)cur.pn * tstep + (size_t)cur.koff * 2;
    S.a_ready(cur);
    if constexpr (SP2) {
        PG8_STAGE(PG8_SB(0, 0), cB, voffB); PG8_STAGE(PG8_SB(0, 1), cB + hstep, voffB); PG8_STAGE(PG8_SA(0, 0), cA, voffA); PG8_STAGE(PG8_SA(0, 1), cA + hstep, voffA);
        if (wr == 1) PG8_BAR;
        PG8_WAIT_V(2); PG8_BAR;
        PG8_STAGE(PG8_SB(1, 0), cB + kstep, voffB); PG8_STAGE(PG8_SA(1, 0), cA + kstep, voffA); PG8_STAGE(PG8_SB(1, 1), cB + hstep + kstep, voffB);
        PG8_WAIT_V(6); PG8_BAR;
    } else {
        PG8_STAGE(PG8_SB(0, 0), cB, voffB); PG8_STAGE(PG8_SA(0, 0), cA, voffA); PG8_STAGE(PG8_SB(0, 1), cB + hstep, voffB); PG8_STAGE(PG8_SA(0, 1), cA + hstep, voffA);
        if (wr == 1) PG8_BAR;
        PG8_WAIT_V(4); PG8_BAR;
        PG8_STAGE(PG8_SB(1, 0), cB + kstep, voffB); PG8_STAGE(PG8_SA(1, 0), cA + kstep, voffA); PG8_STAGE(PG8_SB(1, 1), cB + hstep + kstep, voffB);
        PG8_WAIT_V(6); PG8_BAR;
    }
    for (;;) {
        const bool has_next = S.next(ui + 1, nxt);
        const char* nA = has_next ? (const char*)g.A + (size_t)nxt.pm * tstep + (size_t)nxt.koff * 2 : cA; const char* nB = has_next ? (const char*)g.Bt + (size_t)nxt.pn * tstep + (size_t)nxt.koff * 2 : cB;
        for (int t = 0; t < nt; t += 2) {
            const bool last = (t == nt - 2);
            const char* a1 = cA + (size_t)(t + 1) * kstep;
            const char* a2 = last ? nA : cA + (size_t)(t + 2) * kstep; const char* b2 = last ? nB : cB + (size_t)(t + 2) * kstep;
            const char* a3 = a2 + kstep; const char* b3 = b2 + kstep;
            if (last && has_next) S.a_ready(nxt);
            if constexpr (SP2) {
            PG8_LDB(B0, 0, 0); PG8_LDB(B1, 0, 1); PG8_SCHED; PG8_LDA(At, 0, 0); PG8_STAGE(PG8_SA(1, 1), a1 + hstep, voffA);
            PG8_WAIT_V(8); PG8_WAIT_L(0); PG8_BAR; PG8_MMA(0, 0, At, B0); PG8_MMA(0, 1, At, B1); PG8_BAR; PG8_SCHED;
            PG8_LDA(At, 0, 1); PG8_STAGE(PG8_SB(0, 0), b2, voffB); PG8_STAGE(PG8_SB(0, 1), b2 + hstep, voffB); PG8_STAGE(PG8_SA(0, 0), a2, voffA);
            PG8_WAIT_V(8); PG8_WAIT_L(0); PG8_BAR; PG8_MMA(1, 0, At, B0); PG8_MMA(1, 1, At, B1); PG8_BAR; PG8_SCHED;
            PG8_LDB(B0, 1, 0); PG8_LDB(B1, 1, 1); PG8_SCHED; PG8_LDA(At, 1, 0); PG8_STAGE(PG8_SA(0, 1), a2 + hstep, voffA);
            PG8_WAIT_V(8); PG8_WAIT_L(0); PG8_BAR; PG8_MMA(0, 0, At, B0); PG8_MMA(0, 1, At, B1); PG8_BAR; PG8_SCHED;
            PG8_LDA(At, 1, 1); PG8_STAGE(PG8_SB(1, 0), b3, voffB); PG8_STAGE(PG8_SB(1, 1), b3 + hstep, voffB); PG8_STAGE(PG8_SA(1, 0), a3, voffA);
            PG8_WAIT_V(8); PG8_WAIT_L(0); PG8_BAR; PG8_MMA(1, 0, At, B0); PG8_MMA(1, 1, At, B1); PG8_BAR; PG8_SCHED;
            } else {
            PG8_LDB(B0, 0, 0); PG8_SCHED; PG8_LDA(At, 0, 0); PG8_STAGE(PG8_SA(1, 1), a1 + hstep, voffA);
            PG8_WAIT_L(8); PG8_BAR; PG8_WAIT_L(0); PG8_MMA(0, 0, At, B0); PG8_BAR; PG8_SCHED;
            PG8_LDB(B1, 0, 1); PG8_STAGE(PG8_SB(0, 0), b2, voffB);
            PG8_BAR; PG8_WAIT_L(0); PG8_MMA(0, 1, At, B1); PG8_BAR;
            PG8_LDA(At, 0, 1); PG8_STAGE(PG8_SA(0, 0), a2, voffA);
            PG8_BAR; PG8_WAIT_L(0); PG8_MMA(1, 0, At, B0); PG8_BAR; PG8_SCHED;
            PG8_STAGE(PG8_SB(0, 1), b2 + hstep, voffB);
            PG8_WAIT_V(6); PG8_BAR; PG8_MMA(1, 1, At, B1); PG8_BAR;
            PG8_LDB(B0, 1, 0); PG8_SCHED; PG8_LDA(At, 1, 0); PG8_STAGE(PG8_SA(0, 1), a2 + hstep, voffA);
            PG8_WAIT_L(8); PG8_BAR; PG8_WAIT_L(0); PG8_MMA(0, 0, At, B0); PG8_BAR; PG8_SCHED;
            PG8_LDB(B1, 1, 1); PG8_STAGE(PG8_SB(1, 0), b3, voffB);
            PG8_BAR; PG8_WAIT_L(0); PG8_MMA(0, 1, At, B1); PG8_BAR;
            PG8_LDA(At, 1, 1); PG8_STAGE(PG8_SA(1, 0), a3, voffA);
            PG8_BAR; PG8_WAIT_L(0); PG8_MMA(1, 0, At, B0); PG8_BAR; PG8_SCHED;
            PG8_STAGE(PG8_SB(1, 1), b3 + hstep, voffB);
            PG8_WAIT_V(6); PG8_BAR; PG8_MMA(1, 1, At, B1); PG8_BAR;
            }
        }
        if constexpr (ALIGN_EPI) { if (wr == 0) PG8_BAR; }
        if constexpr (!Epi::AFTER_DRAIN) { E(acc, cur, wr, wc, fr, fq); S.done(cur); }
        if (!has_next) break;
        if (cur.part != 0) {
#pragma unroll
        for (int a = 0; a < 2; ++a)
#pragma unroll
            for (int b = 0; b < 2; ++b)
#pragma unroll
                for (int m = 0; m < 4; ++m)
#pragma unroll
                    for (int n = 0; n < 2; ++n) acc[a][b][m][n] = (f32x4){0.f, 0.f, 0.f, 0.f};
        }
        cur = nxt; cA = nA; cB = nB; ++ui;
        if constexpr (ALIGN_EPI) { if (wr == 1) PG8_BAR; }
    }
    PG8_WAIT_V(0);
    if constexpr (!ALIGN_EPI) { if (wr == 0) PG8_BAR; }
    PG8_BAR;
    if constexpr (Epi::AFTER_DRAIN) { E.fused(acc, cur, wr, wc, fr, fq, lds, wid, lane); S.done(cur); }
#undef PG8_SA
#undef PG8_SB
#undef PG8_STAGE
#undef PG8_LDA
#undef PG8_LDB
#undef PG8_MMA
#undef PG8_WAIT_V
#undef PG8_WAIT_L
#undef PG8_BAR
#undef PG8_SCHED
}
}

using pg8::bf16_t; using pg8::bf16x8; using pg8::f32x4; using pg8::u32x4; using pg8::u32x2; using pg8::cvt_pk_bf16; using pg8::pk4; using pg8::unpk4; using pg8::bf1;
typedef float f32x16 __attribute__((ext_vector_type(16)));
#define LAS __attribute__((address_space(3)))
typedef LAS unsigned char lds_u8;

constexpr int NT_SB = 32768;
constexpr int DM = 1024, NIN = 4352, NUP = 5632, DFF = 2816;
constexpr size_t MiB = 1u << 20;
constexpr size_t WS_TAB = 0, WS_DEC = 16384 * 2, WS_BAR = 65536;
constexpr size_t WS_WIN = 1 * MiB, WS_WAO = 18 * MiB, WS_WRO = 20 * MiB, WS_WOUT = 22 * MiB, WS_WUP = 26 * MiB, WS_WDN = 48 * MiB;
constexpr size_t WS_SS = 60 * MiB, WS_XB = 64 * MiB;
constexpr size_t WS_QA = 128 * MiB, WS_KA = 160 * MiB, WS_VAT = 168 * MiB, WS_QR = 176 * MiB, WS_KR = 192 * MiB, WS_KTF = 208 * MiB, WS_KTB = 224 * MiB,
                 WS_VRT = 240 * MiB, WS_GR = 272 * MiB, WS_GATES = 304 * MiB, WS_AO = 432 * MiB, WS_RG = 464 * MiB, WS_KV = 496 * MiB;
constexpr size_t WS_U = 128 * MiB;
constexpr size_t WS_MG = 560 * MiB, WS_RT = 624 * MiB, WS_ACT = 656 * MiB, WS_END = 832 * MiB;
constexpr int LDS_BYTES = 161024;
constexpr int LDS_RT = 132096, LDS_XCH = 144384;

__device__ __forceinline__ f32x16 mfma32(bf16x8 a, bf16x8 b, f32x16 c) { return __builtin_amdgcn_mfma_f32_32x32x16_bf16(a, b, c, 0, 0, 0); }
__device__ __forceinline__ int crow(int r, int hi) { return (r & 3) + 8 * (r >> 2) + 4 * hi; }
__device__ __forceinline__ int pi32(int r) { return (r & ~12) | ((r & 4) << 1) | ((r & 8) >> 1); }
__device__ __forceinline__ bf16x8 pack8(const f32x16& p, int b) {
    u32x4 w; w.x = cvt_pk_bf16(p[b], p[b + 1]); w.y = cvt_pk_bf16(p[b + 2], p[b + 3]); w.z = cvt_pk_bf16(p[b + 4], p[b + 5]); w.w = cvt_pk_bf16(p[b + 6], p[b + 7]);
    return __builtin_bit_cast(bf16x8, w);
}
__device__ __forceinline__ bf16x8 scale8(bf16x8 q, float s) {
    const u32x4 w = __builtin_bit_cast(u32x4, q); u32x4 o;
#pragma unroll
    for (int i = 0; i < 4; ++i) o[i] = cvt_pk_bf16(__uint_as_float(w[i] << 16) * s, __uint_as_float(w[i] & 0xffff0000u) * s);
    return __builtin_bit_cast(bf16x8, o);
}
__device__ __forceinline__ float wave_sum(float v) {
#pragma unroll
    for (int o = 1; o < 64; o <<= 1) v += __shfl_xor(v, o);
    return v;
}
__device__ __forceinline__ float wave_max(float v) {
#pragma unroll
    for (int o = 1; o < 64; o <<= 1) v = fmaxf(v, __shfl_xor(v, o));
    return v;
}

__device__ __forceinline__ int map_in(int np) { if (np >= 1280) return np; const int pc = np & 255; return (np & ~255) + 64 * ((pc >> 5) & 3) + 32 * (pc >> 7) + (pc & 31); }
__device__ __forceinline__ int map_up(int np) { const int j = np >> 8, pc = np & 255; return pc < 128 ? 128 * j + pc : DFF + 128 * j + (pc - 128); }
template <int MODE> __device__ __forceinline__ void conv_item(const float* __restrict__ W, int K, int N, bf16_t* __restrict__ Wt, int ldw, const float* __restrict__ g, int item, LAS float* scr, int lane) {
    const int nkb = K >> 6, kb = item % nkb, nb = item / nkb, k0 = kb << 6, n0 = nb << 5;
    const int nn = lane & 31, np = n0 + nn, ncol = (MODE == 1) ? map_in(np) : (MODE == 2) ? map_up(np) : np;
    float wv[32];
#pragma unroll
    for (int i = 0; i < 32; ++i) wv[i] = W[(size_t)(k0 + 2 * i + (lane >> 5)) * N + ncol];
    if (g) {
#pragma unroll
        for (int i = 0; i < 32; ++i) wv[i] *= g[k0 + 2 * i + (lane >> 5)];
    }
#pragma unroll
    for (int i = 0; i < 32; ++i) scr[(2 * i + (lane >> 5)) * 33 + nn] = wv[i];
    __builtin_amdgcn_s_waitcnt(0xc07f); __builtin_amdgcn_wave_barrier();
    const int cch = lane & 7;
#pragma unroll
    for (int j = 0; j < 4; ++j) {
        const int n = (lane >> 3) + 8 * j; const LAS float* sp = scr + (8 * cch) * 33 + n;
        u32x4 o; o.x = cvt_pk_bf16(sp[0 * 33], sp[1 * 33]); o.y = cvt_pk_bf16(sp[2 * 33], sp[3 * 33]); o.z = cvt_pk_bf16(sp[4 * 33], sp[5 * 33]); o.w = cvt_pk_bf16(sp[6 * 33], sp[7 * 33]);
        *(u32x4*)(Wt + (size_t)(n0 + n) * ldw + k0 + 8 * cch) = o;
    }
    __builtin_amdgcn_s_waitcnt(0xc07f); __builtin_amdgcn_wave_barrier();
}

__device__ __forceinline__ void attn_unit(const bf16_t* __restrict__ Qa, const bf16_t* __restrict__ Ka, const bf16_t* __restrict__ Vat, bf16_t* __restrict__ AO,
                                          int seq, int kvh, int qb, int S, float negM, lds_u8* lds) {
    const int tid = ltid(), lane = tid & 63, w = __builtin_amdgcn_readfirstlane(tid >> 6), r32 = lane & 31, hi = lane >> 5;
    const int head = kvh * 4 + (w >> 1);
    const size_t tq = (size_t)seq * S + qb * 128 + (w & 1) * 64;
    bf16x8 qr[2][4];
#pragma unroll
    for (int qi = 0; qi < 2; ++qi)
#pragma unroll
        for (int d0 = 0; d0 < 4; ++d0) qr[qi][d0] = *(const bf16x8*)(Qa + (tq + qi * 32 + r32) * 512 + head * 64 + d0 * 16 + hi * 8);
    f32x16 o[2][2];
#pragma unroll
    for (int qi = 0; qi < 2; ++qi)
#pragma unroll
        for (int db = 0; db < 2; ++db)
#pragma unroll
            for (int r = 0; r < 16; ++r) o[qi][db][r] = 0.f;
    float lsum[2] = {0.f, 0.f};
    const bf16_t* Kg = Ka + (size_t)seq * S * 128 + kvh * 64;
    const bf16_t* Vg = Vat + ((size_t)(seq * 2 + kvh) * 64) * S;
    const int sr = tid >> 3, sc = (tid & 7) * 8;
    constexpr int ROWB = 144, TILEB = 64 * ROWB;
    lds_u8* Kl = lds; lds_u8* Vl = lds + 2 * TILEB;
    const int NT = S >> 6;
    u32x4 kreg = *(const u32x4*)(Kg + (size_t)sr * 128 + sc);
    u32x4 vreg = *(const u32x4*)(Vg + (size_t)sr * S + sc);
    *(LAS u32x4*)(Kl + sr * ROWB + sc * 2) = kreg; *(LAS u32x4*)(Vl + sr * ROWB + sc * 2) = vreg;
    __syncthreads();
    const int pr = pi32(r32);
    if (w >= 4) __builtin_amdgcn_s_setprio(1);
    f32x16 negm;
#pragma unroll
    for (int r = 0; r < 16; ++r) negm[r] = negM;
    asm volatile("" : "+v"(negm));
#pragma unroll 1
    for (int t = 0; t < NT; ++t) {
        const int cur = t & 1;
        if (t + 1 < NT) { kreg = *(const u32x4*)(Kg + (size_t)((t + 1) * 64 + sr) * 128 + sc); vreg = *(const u32x4*)(Vg + (size_t)sr * S + (t + 1) * 64 + sc); }
        const lds_u8* Kc = Kl + cur * TILEB; const lds_u8* Vc = Vl + cur * TILEB;
        bf16x8 pa[2][4];
#pragma unroll
        for (int kb = 0; kb < 2; ++kb) {
            bf16x8 kf[4];
#pragma unroll
            for (int d0 = 0; d0 < 4; ++d0) kf[d0] = *(const LAS bf16x8*)(Kc + (kb * 32 + pr) * ROWB + d0 * 32 + hi * 16);
#pragma unroll
            for (int qi = 0; qi < 2; ++qi) {
                f32x16 p = mfma32(kf[0], qr[qi][0], negm);
#pragma unroll
                for (int d0 = 1; d0 < 4; ++d0) p = mfma32(kf[d0], qr[qi][d0], p);
#pragma unroll
                for (int r = 0; r < 16; ++r) p[r] = __builtin_amdgcn_exp2f(p[r]);
                pg8::f32x2 s2 = {p[0], p[1]};
#pragma unroll
                for (int r = 2; r < 16; r += 2) s2 += (pg8::f32x2){p[r], p[r + 1]};
                lsum[qi] += s2.x + s2.y;
                pa[qi][2 * kb] = pack8(p, 0); pa[qi][2 * kb + 1] = pack8(p, 8);
            }
        }
#pragma unroll
        for (int ks = 0; ks < 4; ++ks) {
            const bf16x8 v0 = *(const LAS bf16x8*)(Vc + r32 * ROWB + ks * 32 + hi * 16);
            const bf16x8 v1 = *(const LAS bf16x8*)(Vc + (32 + r32) * ROWB + ks * 32 + hi * 16);
#pragma unroll
            for (int qi = 0; qi < 2; ++qi) { o[qi][0] = mfma32(pa[qi][ks], v0, o[qi][0]); o[qi][1] = mfma32(pa[qi][ks], v1, o[qi][1]); }
        }
        if (t + 1 < NT) { *(LAS u32x4*)(Kl + (cur ^ 1) * TILEB + sr * ROWB + sc * 2) = kreg; *(LAS u32x4*)(Vl + (cur ^ 1) * TILEB + sr * ROWB + sc * 2) = vreg; }
        __syncthreads();
    }
    __builtin_amdgcn_s_setprio(0);
    LAS float* wsf = (LAS float*)(lds + 36864) + w * 64;
    lds_u8* stg = lds + w * 4608;
#pragma unroll
    for (int qi = 0; qi < 2; ++qi) { float l = lsum[qi]; l += __shfl_xor(l, 32); if (hi == 0) wsf[qi * 32 + r32] = l; }
    __builtin_amdgcn_s_waitcnt(0xc07f);
    __builtin_amdgcn_wave_barrier();
#pragma unroll
    for (int qi = 0; qi < 2; ++qi) {
#pragma unroll
        for (int r = 0; r < 16; ++r) {
            const int q = crow(r, hi); const float inv = 1.0f / wsf[qi * 32 + q];
            *(LAS bf16_t*)(stg + q * 144 + r32 * 2) = bf1(o[qi][0][r] * inv); *(LAS bf16_t*)(stg + q * 144 + (32 + r32) * 2) = bf1(o[qi][1][r] * inv);
        }
        __builtin_amdgcn_s_waitcnt(0xc07f);
        __builtin_amdgcn_wave_barrier();
#pragma unroll
        for (int i = 0; i < 4; ++i) {
            const int row = i * 8 + (lane >> 3), ch = lane & 7;
            const u32x4 yv = *(const LAS u32x4*)(stg + row * 144 + ch * 16);
            *(u32x4*)(AO + (tq + qi * 32 + row) * 1024 + head * 64 + ch * 8) = yv;
        }
        __builtin_amdgcn_s_waitcnt(0xc07f);
        __builtin_amdgcn_wave_barrier();
    }
    __syncthreads();
}

constexpr int R1_VT = 0, R1_KF = 34816, R1_KB = 52224, R1_BYTES = 69632;
struct R1Regs { u32x4 v[4], kf[2], kb[2]; };
__device__ __forceinline__ void r1_load(R1Regs& g, const bf16_t* __restrict__ Vrt, const bf16_t* __restrict__ Ktf, const bf16_t* __restrict__ Ktb, int u, int S, int sshift, int tid) {
    const int chunk = u >> 2, h = u & 3, t0 = chunk * 128, seq = t0 >> sshift, s0 = t0 & (S - 1);
#pragma unroll
    for (int i = 0; i < 4; ++i) { const int id = tid + i * 512, row = id >> 4, cc = (id & 15) * 8; g.v[i] = *(const u32x4*)(Vrt + ((size_t)(seq * 4 + h) * 128 + row) * S + s0 + cc); }
#pragma unroll
    for (int i = 0; i < 2; ++i) { const int id = tid + i * 512, row = id >> 4, cc = (id & 15) * 8; const size_t o = ((size_t)(seq * 4 + h) * 64 + row) * S + s0 + cc;
        g.kf[i] = *(const u32x4*)(Ktf + o); g.kb[i] = *(const u32x4*)(Ktb + o); }
}
__device__ __forceinline__ void r1_phase(const bf16_t* __restrict__ Vrt, const bf16_t* __restrict__ Ktf, const bf16_t* __restrict__ Ktb, float* __restrict__ KV, int S, int sshift, int G, int bx, lds_u8* lds) {
    const int tid = ltid(), lane = tid & 63, w = __builtin_amdgcn_readfirstlane(tid >> 6), r32 = lane & 31, hi = lane >> 5;
    const int dir = w & 1, dvb = w >> 1;
    const int NU = (NT_SB / 128) * 4;
    R1Regs g;
    int u = bx;
    if (u < NU) r1_load(g, Vrt, Ktf, Ktb, u, S, sshift, tid);
#pragma unroll 1
    for (; u < NU; u += G) {
        const int chunk = u >> 2, h = u & 3;
#pragma unroll
        for (int i = 0; i < 4; ++i) { const int id = tid + i * 512, row = id >> 4, cb = (id & 15) * 16; *(LAS u32x4*)(lds + R1_VT + row * 272 + cb) = g.v[i]; }
#pragma unroll
        for (int i = 0; i < 2; ++i) { const int id = tid + i * 512, row = id >> 4, cb = (id & 15) * 16; *(LAS u32x4*)(lds + R1_KF + row * 272 + cb) = g.kf[i]; *(LAS u32x4*)(lds + R1_KB + row * 272 + cb) = g.kb[i]; }
        __syncthreads();
        if (u + G < NU) r1_load(g, Vrt, Ktf, Ktb, u + G, S, sshift, tid);
        f32x16 acc[2];
#pragma unroll
        for (int b = 0; b < 2; ++b)
#pragma unroll
            for (int r = 0; r < 16; ++r) acc[b][r] = 0.f;
        const lds_u8* Kt = lds + (dir ? R1_KB : R1_KF);
#pragma unroll
        for (int ks = 0; ks < 8; ++ks) {
            const bf16x8 va = *(const LAS bf16x8*)(lds + R1_VT + (dvb * 32 + r32) * 272 + ks * 32 + hi * 16);
#pragma unroll
            for (int b = 0; b < 2; ++b) { const bf16x8 kb = *(const LAS bf16x8*)(Kt + (b * 32 + r32) * 272 + ks * 32 + hi * 16); acc[b] = mfma32(va, kb, acc[b]); }
        }
        float* out = KV + ((size_t)(chunk * 4 + h) * 2 + dir) * 8192;
#pragma unroll
        for (int b = 0; b < 2; ++b)
#pragma unroll
            for (int r = 0; r < 16; ++r) out[(dvb * 32 + crow(r, hi)) * 64 + b * 32 + r32] = acc[b][r];
        __syncthreads();
    }
}

constexpr int R3_KT = 0, R3_QT = 18432, R3_VT = 36864, R3_RF = 71680, R3_RB = 90112, R3_PART = 108544, R3_BYTES = 109568;
struct R3Regs { u32x4 k[2], q[2], v[4], rf[2], rb[2]; };
__device__ __forceinline__ void r3_load(R3Regs& g, const bf16_t* __restrict__ Qr, const bf16_t* __restrict__ Kr, const bf16_t* __restrict__ Vrt, const bf16_t* __restrict__ RT, int u, int S, int sshift, int tid) {
    const int chunk = u >> 2, h = u & 3, t0 = chunk * 128, seq = t0 >> sshift, s0 = t0 & (S - 1);
#pragma unroll
    for (int i = 0; i < 2; ++i) { const int id = tid + i * 512, row = id >> 3, cc = (id & 7) * 8;
        g.k[i] = *(const u32x4*)(Kr + (size_t)(t0 + row) * 256 + h * 64 + cc); g.q[i] = *(const u32x4*)(Qr + (size_t)(t0 + row) * 256 + h * 64 + cc);
        g.rf[i] = *(const u32x4*)(RT + ((size_t)(chunk * 4 + h) * 2) * 8192 + id * 8); g.rb[i] = *(const u32x4*)(RT + ((size_t)(chunk * 4 + h) * 2 + 1) * 8192 + id * 8); }
#pragma unroll
    for (int i = 0; i < 4; ++i) { const int id = tid + i * 512, row = id >> 4, cc = (id & 15) * 8;
        g.v[i] = *(const u32x4*)(Vrt + ((size_t)(seq * 4 + h) * 128 + row) * S + s0 + cc); }
}
__device__ __forceinline__ void r3_stage(const R3Regs& g, lds_u8* lds, int tid) {
#pragma unroll
    for (int i = 0; i < 2; ++i) { const int id = tid + i * 512, row = id >> 3, cb = (id & 7) * 16;
        *(LAS u32x4*)(lds + R3_KT + row * 144 + cb) = g.k[i]; *(LAS u32x4*)(lds + R3_QT + row * 144 + cb) = g.q[i];
        *(LAS u32x4*)(lds + R3_RF + row * 144 + cb) = g.rf[i]; *(LAS u32x4*)(lds + R3_RB + row * 144 + cb) = g.rb[i]; }
#pragma unroll
    for (int i = 0; i < 4; ++i) { const int id = tid + i * 512, row = id >> 4, cb = (id & 15) * 16; *(LAS u32x4*)(lds + R3_VT + row * 272 + cb) = g.v[i]; }
}
__device__ __forceinline__ void r3_phase(const bf16_t* __restrict__ Qr, const bf16_t* __restrict__ Kr, const bf16_t* __restrict__ Vrt, const bf16_t* __restrict__ RT,
                                         const bf16_t* __restrict__ Gr, bf16_t* __restrict__ RG, const float* __restrict__ dec2, int S, int sshift, int G, int bx, lds_u8* lds) {
    const int tid = ltid(), lane = tid & 63, w = __builtin_amdgcn_readfirstlane(tid >> 6), r32 = lane & 31, hi = lane >> 5;
    const int qblk = w >> 1, dvh = w & 1;
    const int NU = (NT_SB / 128) * 4;
    R3Regs g;
    int u = bx;
    if (u < NU) r3_load(g, Qr, Kr, Vrt, RT, u, S, sshift, tid);
    const int pr = pi32(r32);
#pragma unroll 1
    for (; u < NU; u += G) {
        const int chunk = u >> 2, h = u & 3, t0 = chunk * 128;
        const float lf2 = dec2[h], lb2 = dec2[4 + h];
        r3_stage(g, lds, tid);
        __syncthreads();
        if (u + G < NU) r3_load(g, Qr, Kr, Vrt, RT, u + G, S, sshift, tid);
        const int iq = qblk * 32 + r32;
        bf16x8 qraw[4];
#pragma unroll
        for (int d0 = 0; d0 < 4; ++d0) qraw[d0] = *(const LAS bf16x8*)(lds + R3_QT + iq * 144 + d0 * 32 + hi * 16);
        const float sf = __builtin_amdgcn_exp2f(lf2 * (float)(iq + 1)), sb = __builtin_amdgcn_exp2f(lb2 * (float)(128 - iq));
        f32x16 acc[2];
#pragma unroll
        for (int a = 0; a < 2; ++a)
#pragma unroll
            for (int r = 0; r < 16; ++r) acc[a][r] = 0.f;
#pragma unroll
        for (int d0 = 0; d0 < 4; ++d0) {
            const bf16x8 qf = scale8(qraw[d0], sf), qb = scale8(qraw[d0], sb);
#pragma unroll
            for (int a = 0; a < 2; ++a) {
                const int dv = dvh * 64 + a * 32 + r32;
                const bf16x8 rf = *(const LAS bf16x8*)(lds + R3_RF + dv * 144 + d0 * 32 + hi * 16);
                const bf16x8 rb = *(const LAS bf16x8*)(lds + R3_RB + dv * 144 + d0 * 32 + hi * 16);
                acc[a] = mfma32(qf, rf, acc[a]); acc[a] = mfma32(qb, rb, acc[a]);
            }
        }
#pragma unroll
        for (int kb = 0; kb < 4; ++kb) {
            f32x16 st;
#pragma unroll
            for (int r = 0; r < 16; ++r) st[r] = 0.f;
#pragma unroll
            for (int d0 = 0; d0 < 4; ++d0) {
                const bf16x8 kf = *(const LAS bf16x8*)(lds + R3_KT + (kb * 32 + pr) * 144 + d0 * 32 + hi * 16);
                st = mfma32(kf, qraw[d0], st);
            }
#pragma unroll
            for (int r = 0; r < 16; ++r) {
                const int j = kb * 32 + 16 * (r >> 3) + 8 * hi + (r & 7);
                const float dd = (float)(iq - j);
                const float e = (dd >= 0.f) ? lf2 * dd : -lb2 * dd;
                st[r] *= __builtin_amdgcn_exp2f(e);
            }
            bf16x8 pa[2]; pa[0] = pack8(st, 0); pa[1] = pack8(st, 8);
#pragma unroll
            for (int s = 0; s < 2; ++s)
#pragma unroll
                for (int a = 0; a < 2; ++a) {
                    const bf16x8 vf = *(const LAS bf16x8*)(lds + R3_VT + (dvh * 64 + a * 32 + r32) * 272 + kb * 64 + s * 32 + hi * 16);
                    acc[a] = mfma32(pa[s], vf, acc[a]);
                }
        }
        LAS float* part = (LAS float*)(lds + R3_PART);
        float ssq[16];
#pragma unroll
        for (int r = 0; r < 16; ++r) {
            float q = acc[0][r] * acc[0][r] + acc[1][r] * acc[1][r];
            q += __shfl_xor(q, 1); q += __shfl_xor(q, 2); q += __shfl_xor(q, 4); q += __shfl_xor(q, 8); q += __shfl_xor(q, 16);
            ssq[r] = q;
            if (r32 == 0) part[(qblk * 2 + dvh) * 32 + crow(r, hi)] = q;
        }
        __syncthreads();
        lds_u8* stg = lds + w * 4608;
#pragma unroll
        for (int r = 0; r < 16; ++r) {
            const int qrow = crow(r, hi);
            const float tot = ssq[r] + part[(qblk * 2 + (dvh ^ 1)) * 32 + qrow];
            const float inv = rsqrtf(tot * (1.0f / 128.0f) + EPS_F);
#pragma unroll
            for (int a = 0; a < 2; ++a) *(LAS bf16_t*)(stg + qrow * 144 + (a * 32 + r32) * 2) = bf1(acc[a][r] * inv);
        }
        __builtin_amdgcn_s_waitcnt(0xc07f);
        __builtin_amdgcn_wave_barrier();
#pragma unroll
        for (int i = 0; i < 4; ++i) {
            const int row = i * 8 + (lane >> 3), ch = lane & 7;
            const u32x4 yv = *(const LAS u32x4*)(stg + row * 144 + ch * 16);
            const size_t o = (size_t)(t0 + qblk * 32 + row) * 512 + h * 128 + dvh * 64 + ch * 8;
            const u32x4 gv = *(const u32x4*)(Gr + o);
            u32x4 ov;
#pragma unroll
            for (int e = 0; e < 4; ++e) ov[e] = cvt_pk_bf16(__uint_as_float(yv[e] << 16) * __uint_as_float(gv[e] << 16), __uint_as_float(yv[e] & 0xffff0000u) * __uint_as_float(gv[e] & 0xffff0000u));
            *(u32x4*)(RG + (size_t)(t0 + qblk * 32 + row) * 1024 + 512 + h * 128 + dvh * 64 + ch * 8) = ov;
        }
        __syncthreads();
    }
}

#define XB_TMO      128
#define XB_XCNT(j)  (256  + 64 * (j))
#define XB_XSUB(j)  (1280 + 64 * (j))
#define XB_XGEN(j)  (2304 + 64 * (j))
#define XB_TOP      3328
#define XB_TOPGEN   3392
#define XCD_BAR_WORDS 3456
#define XB_SPIN_CAP (1u << 18)

__device__ __forceinline__ unsigned xb_ld(unsigned* p)              { return __hip_atomic_load(p, __ATOMIC_RELAXED, __HIP_MEMORY_SCOPE_AGENT); }
__device__ __forceinline__ unsigned xb_add(unsigned* p, unsigned v) { return __hip_atomic_fetch_add(p, v, __ATOMIC_RELAXED, __HIP_MEMORY_SCOPE_AGENT); }
__device__ __forceinline__ unsigned xb_xcc_id() { return (unsigned)__builtin_amdgcn_s_getreg((3 << 11) | 20) & 0xFu; }
#define XB_SPIN(cond, bar) do { unsigned _sp = 0; while (cond) { __builtin_amdgcn_s_sleep(1); \
    if ((++_sp & 255u) == 0u) { if (xb_ld(&(bar)[XB_TMO])) break; if (_sp > XB_SPIN_CAP) { atomicAdd(&(bar)[XB_TMO], 1u); break; } } } } while (0)

struct XcdBarrier {
    unsigned* bar; unsigned x;
    volatile LAS unsigned* st;
};

__device__ __forceinline__ XcdBarrier xcd_barrier_post(unsigned* bar, volatile LAS unsigned* st) {
    XcdBarrier b; b.bar = bar; b.x = xb_xcc_id(); b.st = st;
    if (threadIdx.x == 0) (void)xb_add(&bar[XB_XCNT(b.x)], 1u);
    return b;
}
__device__ __forceinline__ void xcd_barrier_complete(unsigned* bar, unsigned x, unsigned& nloc, unsigned& nx) {
    const unsigned G = gridDim.x * gridDim.y * gridDim.z;
    unsigned sum, cnt, mine, sp = 0u;
    for (;;) {
        sum = 0u; cnt = 0u; mine = 0u;
#pragma unroll
        for (unsigned j = 0; j < 16; ++j) { const unsigned c = xb_ld(&bar[XB_XCNT(j)]); sum += c; cnt += (c > 0u) ? 1u : 0u; mine = (j == x) ? c : mine; }
        if (sum == G) break;
        __builtin_amdgcn_s_sleep(1);
        if ((++sp & 255u) == 0u) { if (xb_ld(&bar[XB_TMO])) break; if (sp > XB_SPIN_CAP) { atomicAdd(&bar[XB_TMO], 1u); break; } }
    }
    nloc = mine > 0u ? mine : 1u; nx = cnt > 0u ? cnt : 1u;
}

__device__ __forceinline__ void xcd_barrier(const XcdBarrier& b) {
    asm volatile("s_waitcnt vmcnt(0)" ::: "memory");
    __syncthreads();
    if (threadIdx.x == 0) {
        unsigned* bar = b.bar;
        __builtin_amdgcn_s_waitcnt(0);
        unsigned nloc = b.st[0], nx = b.st[1];
        if (nloc == 0u) { xcd_barrier_complete(bar, b.x, nloc, nx); b.st[0] = nloc; b.st[1] = nx; }
        const unsigned old = xb_add(&bar[XB_XSUB(b.x)], 1u);
        const unsigned gen = old / nloc;
        if (old + 1u == (gen + 1u) * nloc) {
            __builtin_amdgcn_fence(__ATOMIC_RELEASE, "agent");
            asm volatile("s_waitcnt vmcnt(0)" ::: "memory");
            const unsigned og = xb_add(&bar[XB_TOP], 1u);
            const unsigned tg = og / nx;
            if (og + 1u == (tg + 1u) * nx) xb_add(&bar[XB_TOPGEN], 1u);
            else XB_SPIN(xb_ld(&bar[XB_TOPGEN]) == tg, bar);
            __builtin_amdgcn_fence(__ATOMIC_ACQUIRE, "agent");
            xb_add(&bar[XB_XGEN(b.x)], 1u);
            asm volatile("s_waitcnt vmcnt(0)" ::: "memory");
        } else {
            XB_SPIN(xb_ld(&bar[XB_XGEN(b.x)]) == gen, bar);
            __builtin_amdgcn_fence(__ATOMIC_ACQUIRE, "agent");
            asm volatile("s_waitcnt vmcnt(0)" ::: "memory");
        }
    }
    __syncthreads();
}

struct Args { const float* in[17]; float* out; unsigned char* ws; };
typedef __attribute__((address_space(4))) const Args CArgs;
__device__ __forceinline__ CArgs* kargs() { CArgs* p = (CArgs*)__builtin_amdgcn_kernarg_segment_ptr(); asm volatile("" : "+s"(p)); return p; }
#define WSP(T, off) ((T*)(ws + (off)))

__global__ void __launch_bounds__(512, 2) fwd_megakernel(Args a_unused) {
    extern __shared__ __attribute__((aligned(16))) unsigned char lds_raw[];
    cg::grid_group grid = cg::this_grid();
    lds_u8* lds = (lds_u8*)lds_raw;
    const int G = gridDim.x, bx = blockIdx.x;
    XcdBarrier bar;
    {
        volatile LAS unsigned* st = (volatile LAS unsigned*)(lds + 131072);
        if (threadIdx.x < 2) st[threadIdx.x] = 0u;
        __syncthreads();
        CArgs* A = kargs(); bar = xcd_barrier_post((unsigned*)(A->ws + WS_BAR), st);
    }
    if (gridDim.x == 0x7fffffffu) grid.sync();

    {
        CArgs* A = kargs(); unsigned char* ws = A->ws; const int tid = ltid(), lane = tid & 63, wave = __builtin_amdgcn_readfirstlane(tid >> 6); (void)lane; (void)wave;
        if (bx == 0) {
            float* decs = WSP(float, WS_DEC);
            if (tid < 16) { const int l = tid >> 3, j = tid & 7; const float x = (j < 4) ? A->in[6][l * 4 + j] : A->in[7][l * 4 + j - 4];
                decs[tid] = -log1pf(expf(-x)) * 1.4426950408889634f; }
        }
        LAS float* scr = (LAS float*)lds + wave * (64 * 33);
        constexpr int I_IN = 16 * 136, I_AO = 8 * 32, I_OUT = 16 * 32, I_UP = 16 * 176, I_DN = 44 * 32, I_L = I_IN + 2 * I_AO + I_OUT + I_UP + I_DN;
#pragma unroll 1
        for (int it = bx * 8 + wave; it < 2 * I_L; it += G * 8) {
            const int l = it / I_L; int r = it % I_L;
            if (r < I_IN) { conv_item<1>(A->in[3] + (size_t)l * DM * NIN, DM, NIN, WSP(bf16_t, WS_WIN) + (size_t)l * NIN * DM, DM, A->in[2] + l * DM, r, scr, lane); continue; } r -= I_IN;
            if (r < I_AO) { conv_item<0>(A->in[8] + (size_t)l * 512 * DM, 512, DM, WSP(bf16_t, WS_WAO) + (size_t)l * DM * DM, DM, nullptr, r, scr, lane); continue; } r -= I_AO;
            if (r < I_AO) { conv_item<0>(A->in[9] + (size_t)l * 512 * DM, 512, DM, WSP(bf16_t, WS_WAO) + (size_t)l * DM * DM + 512, DM, nullptr, r, scr, lane); continue; } r -= I_AO;
            if (r < I_OUT) { conv_item<0>(A->in[11] + (size_t)l * DM * DM, DM, DM, WSP(bf16_t, WS_WOUT) + (size_t)l * DM * DM, DM, nullptr, r, scr, lane); continue; } r -= I_OUT;
            if (r < I_UP) { conv_item<2>(A->in[13] + (size_t)l * DM * NUP, DM, NUP, WSP(bf16_t, WS_WUP) + (size_t)l * NUP * DM, DM, A->in[12] + l * DM, r, scr, lane); continue; } r -= I_UP;
            conv_item<0>(A->in[16] + (size_t)l * DFF * DM, DFF, DM, WSP(bf16_t, WS_WDN) + (size_t)l * DM * DFF, DFF, nullptr, r, scr, lane);
        }
    }

#pragma unroll 1
    for (int sb = 0; sb < 3; ++sb) {
        {
            CArgs* A = kargs(); unsigned char* ws = A->ws; const int tid = ltid(), lane = tid & 63, wave = __builtin_amdgcn_readfirstlane(tid >> 6); (void)lane; (void)wave;
            const float* xin = (sb == 0) ? A->in[0] : A->in[1] + (size_t)(sb - 1) * NT_SB * DM;
            bf16_t* xb = WSP(bf16_t, WS_XB); float* ss = WSP(float, WS_SS);
            const int gw = bx * 8 + wave, NGW = G * 8;
#pragma unroll 1
            for (int row = gw; row < NT_SB; row += 4 * NGW) {
                f32x4 v[4][4]; float q[4];
#pragma unroll
                for (int rr = 0; rr < 4; ++rr) { const int r1 = (row + rr * NGW < NT_SB) ? row + rr * NGW : row; const f32x4* xr = (const f32x4*)(xin + (size_t)r1 * DM) + lane;
#pragma unroll
                    for (int j = 0; j < 4; ++j) v[rr][j] = xr[64 * j]; }
#pragma unroll
                for (int rr = 0; rr < 4; ++rr) { float qq = 0.f;
#pragma unroll
                    for (int j = 0; j < 4; ++j) qq += (v[rr][j][0] * v[rr][j][0] + v[rr][j][1] * v[rr][j][1]) + (v[rr][j][2] * v[rr][j][2] + v[rr][j][3] * v[rr][j][3]);
                    q[rr] = wave_sum(qq); }
#pragma unroll
                for (int rr = 0; rr < 4; ++rr) { const int r2 = row + rr * NGW; if (r2 >= NT_SB) continue;
                    u32x2* o8 = (u32x2*)(xb + (size_t)r2 * DM) + lane;
#pragma unroll
                    for (int j = 0; j < 4; ++j) o8[64 * j] = pk4(v[rr][j]);
                    if (lane < 16) ss[(size_t)r2 * 16 + lane] = (lane == 0) ? q[rr] : 0.f; }
            }
        }
        xcd_barrier(bar);
#pragma unroll 1
        for (int l = 0; l < 2; ++l) {
            {
                CArgs* A = kargs(); unsigned char* ws = A->ws; const int tid = ltid(), lane = tid & 63, wave = __builtin_amdgcn_readfirstlane(tid >> 6); (void)lane; (void)wave;
                const int S = (sb == 0) ? 8192 : 2048, sshift = (sb == 0) ? 13 : 11;
                pg8::Gemm g{WSP(bf16_t, WS_XB), WSP(bf16_t, WS_WIN) + (size_t)l * NIN * DM, NT_SB, NIN, DM, DM}; pg8::StaticOrder So; So.init(NT_SB, NIN, G, bx);
                pg8::rstd_table(WSP(float, WS_SS), So, (LAS float*)(lds + LDS_RT));
                pg8::EpiIn E{(pg8::lds_cf*)(lds + LDS_RT), A->in[4] + l * 64, A->in[5] + l * 64, A->in[10] + l * 2048, WSP(float, WS_DEC) + l * 8,
                             WSP(bf16_t, WS_QA), WSP(bf16_t, WS_KA), WSP(bf16_t, WS_VAT), WSP(bf16_t, WS_QR), WSP(bf16_t, WS_KR), WSP(bf16_t, WS_KTF), WSP(bf16_t, WS_KTB),
                             WSP(bf16_t, WS_VRT), WSP(bf16_t, WS_GR), WSP(bf16_t, WS_GATES), S, sshift};
                pg8::gemm_phase<pg8::EpiIn, pg8::StaticOrder, true, true>(lds, g, So, E);
            }
            xcd_barrier(bar);
            {
                CArgs* A = kargs(); unsigned char* ws = A->ws; const int tid = ltid(), lane = tid & 63, wave = __builtin_amdgcn_readfirstlane(tid >> 6); (void)lane; (void)wave;
                const int S = (sb == 0) ? 8192 : 2048, sshift = (sb == 0) ? 13 : 11;
                const float mq = wave_max(fabsf(A->in[4][l * 64 + lane])), mk = wave_max(fabsf(A->in[5][l * 64 + lane]));
                const float negM = -11.541560327111707f * mq * mk;
                const int nq = S >> 7, nunits = (NT_SB / S) * 2 * nq;
#pragma unroll 1
                for (int u = bx; u < nunits; u += G) {
                    const int qb = u % nq, kvh = (u / nq) & 1, seq = u / (2 * nq);
                    attn_unit(WSP(bf16_t, WS_QA), WSP(bf16_t, WS_KA), WSP(bf16_t, WS_VAT), WSP(bf16_t, WS_AO), seq, kvh, qb, S, negM, lds);
                }
                r1_phase(WSP(bf16_t, WS_VRT), WSP(bf16_t, WS_KTF), WSP(bf16_t, WS_KTB), WSP(float, WS_KV), S, sshift, G, bx, lds);
            }
            xcd_barrier(bar);
            {
                CArgs* A = kargs(); unsigned char* ws = A->ws; const int tid = ltid(), lane = tid & 63, wave = __builtin_amdgcn_readfirstlane(tid >> 6); (void)lane; (void)wave;
                const int S = (sb == 0) ? 8192 : 2048;
                const float* dec2 = WSP(float, WS_DEC) + l * 8; const float* KV = WSP(float, WS_KV); bf16_t* RT = WSP(bf16_t, WS_RT);
                const int nc = S >> 7, nscan = (NT_SB / S) * 8 * 8192;
#pragma unroll 1
                for (int idx = bx * 512 + tid; idx < nscan; idx += G * 512) {
                    const int e = idx & 8191, rest = idx >> 13, dir = rest & 1, h = (rest >> 1) & 3, seq = rest >> 3;
                    const float dC = exp2f(dec2[dir * 4 + h] * 128.0f);
                    const size_t base = ((size_t)(seq * nc) * 4 + h) * 2 + dir;
                    float R = 0.f;
#pragma unroll 1
                    for (int cb = 0; cb < nc; cb += 16) {
                        float kv[16];
#pragma unroll
                        for (int i = 0; i < 16; ++i) { const int c = dir ? (nc - 1 - cb - i) : (cb + i); kv[i] = KV[(base + (size_t)c * 8) * 8192 + e]; }
#pragma unroll
                        for (int i = 0; i < 16; ++i) { const int c = dir ? (nc - 1 - cb - i) : (cb + i); RT[(base + (size_t)c * 8) * 8192 + e] = bf1(R); R = dC * R + kv[i]; }
                    }
                }
            }
            xcd_barrier(bar);
            {
                CArgs* A = kargs(); unsigned char* ws = A->ws; const int tid = ltid(), lane = tid & 63, wave = __builtin_amdgcn_readfirstlane(tid >> 6); (void)lane; (void)wave;
                const int S = (sb == 0) ? 8192 : 2048, sshift = (sb == 0) ? 13 : 11;
                r3_phase(WSP(bf16_t, WS_QR), WSP(bf16_t, WS_KR), WSP(bf16_t, WS_VRT), WSP(bf16_t, WS_RT), WSP(bf16_t, WS_GR), WSP(bf16_t, WS_AO), WSP(float, WS_DEC) + l * 8, S, sshift, G, bx, lds);
            }
            xcd_barrier(bar);
            {
                CArgs* A = kargs(); unsigned char* ws = A->ws; const int tid = ltid(), lane = tid & 63, wave = __builtin_amdgcn_readfirstlane(tid >> 6); (void)lane; (void)wave;
                pg8::PairOrder So; So.init(NT_SB, DM, G, bx, 512);
                pg8::Gemm g{WSP(bf16_t, WS_AO), WSP(bf16_t, WS_WAO) + (size_t)l * DM * DM, NT_SB, DM, 512, DM}; pg8::EpiMergeF E{WSP(bf16_t, WS_GATES), WSP(bf16_t, WS_MG)};
                pg8::gemm_phase<pg8::EpiMergeF, pg8::PairOrder, true, true>(lds, g, So, E);
            }
            xcd_barrier(bar);
            {
                CArgs* A = kargs(); unsigned char* ws = A->ws; const int tid = ltid(), lane = tid & 63, wave = __builtin_amdgcn_readfirstlane(tid >> 6); (void)lane; (void)wave;
                pg8::Gemm g{WSP(bf16_t, WS_MG), WSP(bf16_t, WS_WOUT) + (size_t)l * DM * DM, NT_SB, DM, DM, DM}; pg8::StaticOrder So; So.init(NT_SB, DM, G, bx);
                pg8::EpiResid<false> E{WSP(bf16_t, WS_XB), nullptr, WSP(float, WS_SS)};
                pg8::gemm_phase<pg8::EpiResid<false>, pg8::StaticOrder, true, true>(lds, g, So, E);
            }
            xcd_barrier(bar);
            {
                CArgs* A = kargs(); unsigned char* ws = A->ws; const int tid = ltid(), lane = tid & 63, wave = __builtin_amdgcn_readfirstlane(tid >> 6); (void)lane; (void)wave;
                pg8::Gemm g{WSP(bf16_t, WS_XB), WSP(bf16_t, WS_WUP) + (size_t)l * NUP * DM, NT_SB, NUP, DM, DM}; pg8::StaticOrder So; So.init(NT_SB, NUP, G, bx);
                pg8::rstd_table(WSP(float, WS_SS), So, (LAS float*)(lds + LDS_RT));
                pg8::EpiUpConv E{(pg8::lds_cf*)(lds + LDS_RT), (pg8::lds_f*)(lds + LDS_XCH), A->in[14] + (size_t)l * 3 * NUP, A->in[15] + (size_t)l * NUP, WSP(bf16_t, WS_ACT), WSP(bf16_t, WS_U)};
                pg8::gemm_phase<pg8::EpiUpConv, pg8::StaticOrder, true, true>(lds, g, So, E);
            }
            xcd_barrier(bar);
            {
                CArgs* A = kargs(); unsigned char* ws = A->ws; const int tid = ltid(), lane = tid & 63, wave = __builtin_amdgcn_readfirstlane(tid >> 6); (void)lane; (void)wave;
                const int S = (sb == 0) ? 8192 : 2048;
                const bf16_t* UE = WSP(bf16_t, WS_U); bf16_t* ACT = WSP(bf16_t, WS_ACT);
                const float* cw = A->in[14] + (size_t)l * 3 * NUP; const float* cb = A->in[15] + (size_t)l * NUP;
                constexpr int NCG = DFF / 8, NITEM = (NT_SB / 256) * 2 * NCG;
#pragma unroll 1
                for (int it = bx * 512 + tid; it < NITEM; it += G * 512) {
                    const int cgp = it % NCG, pe = it / NCG, p = pe >> 1, eg = pe & 1, v0 = cgp * 8;
                    const int t = p * 256 + (eg ? 255 : 0);
                    const int ucol = 256 * (v0 >> 7) + (v0 & 127);
                    const u32x4 zero = {0u, 0u, 0u, 0u};
                    u32x4 rw[3][2];
                    const bf16_t* r0; const bf16_t* r1; const bf16_t* r2; bool hp, hn;
                    if (eg == 0) { hp = (t & (S - 1)) != 0; hn = true; r0 = UE + ((size_t)(p - 1) * 4 + 3) * NUP; r1 = UE + ((size_t)p * 4 + 0) * NUP; r2 = UE + ((size_t)p * 4 + 1) * NUP; }
                    else { hp = true; hn = ((t + 1) & (S - 1)) != 0; r0 = UE + ((size_t)p * 4 + 2) * NUP; r1 = UE + ((size_t)p * 4 + 3) * NUP; r2 = UE + ((size_t)(p + 1) * 4 + 0) * NUP; }
#pragma unroll
                    for (int pp = 0; pp < 2; ++pp) {
                        rw[0][pp] = hp ? *(const u32x4*)(r0 + ucol + pp * 128) : zero;
                        rw[1][pp] = *(const u32x4*)(r1 + ucol + pp * 128);
                        rw[2][pp] = hn ? *(const u32x4*)(r2 + ucol + pp * 128) : zero;
                    }
                    float r[2][8];
#pragma unroll
                    for (int pp = 0; pp < 2; ++pp) {
                        float wv[3][8], bv[8];
#pragma unroll
                        for (int k = 0; k < 3; ++k) { const f32x4 x0 = *(const f32x4*)(cw + k * NUP + pp * DFF + v0), x1 = *(const f32x4*)(cw + k * NUP + pp * DFF + v0 + 4);
#pragma unroll
                            for (int e = 0; e < 4; ++e) { wv[k][e] = x0[e]; wv[k][4 + e] = x1[e]; } }
                        const f32x4 y0 = *(const f32x4*)(cb + pp * DFF + v0), y1 = *(const f32x4*)(cb + pp * DFF + v0 + 4);
#pragma unroll
                        for (int e = 0; e < 4; ++e) { bv[e] = y0[e]; bv[4 + e] = y1[e]; }
#pragma unroll
                        for (int e2 = 0; e2 < 4; ++e2) {
                            const float a0 = __uint_as_float(rw[0][pp][e2] << 16), a1 = __uint_as_float(rw[0][pp][e2] & 0xffff0000u);
                            const float b0 = __uint_as_float(rw[1][pp][e2] << 16), b1 = __uint_as_float(rw[1][pp][e2] & 0xffff0000u);
                            const float c0 = __uint_as_float(rw[2][pp][e2] << 16), c1 = __uint_as_float(rw[2][pp][e2] & 0xffff0000u);
                            r[pp][2 * e2] = a0 * wv[0][2 * e2] + b0 * wv[1][2 * e2] + c0 * wv[2][2 * e2] + bv[2 * e2];
                            r[pp][2 * e2 + 1] = a1 * wv[0][2 * e2 + 1] + b1 * wv[1][2 * e2 + 1] + c1 * wv[2][2 * e2 + 1] + bv[2 * e2 + 1];
                        }
                    }
                    u32x4 o;
#pragma unroll
                    for (int e2 = 0; e2 < 4; ++e2) {
                        const pg8::f32x2 gl = pg8::gelu_pk((pg8::f32x2){r[1][2 * e2], r[1][2 * e2 + 1]});
                        o[e2] = cvt_pk_bf16(gl.x * r[0][2 * e2], gl.y * r[0][2 * e2 + 1]);
                    }
                    *(u32x4*)(ACT + (size_t)t * DFF + v0) = o;
                }
            }
            xcd_barrier(bar);
            {
                CArgs* A = kargs(); unsigned char* ws = A->ws; const int tid = ltid(), lane = tid & 63, wave = __builtin_amdgcn_readfirstlane(tid >> 6); (void)lane; (void)wave;
                float* xout = A->out + (size_t)sb * NT_SB * DM;
                pg8::Gemm g{WSP(bf16_t, WS_ACT), WSP(bf16_t, WS_WDN) + (size_t)l * DM * DFF, NT_SB, DM, DFF, DFF}; pg8::StaticOrder So; So.init(NT_SB, DM, G, bx);
                if (l == 0) { pg8::EpiResid<false> E{WSP(bf16_t, WS_XB), nullptr, WSP(float, WS_SS)}; pg8::gemm_phase<pg8::EpiResid<false>, pg8::StaticOrder, true, true>(lds, g, So, E); }
                else { pg8::EpiResid<true> E{WSP(bf16_t, WS_XB), xout, nullptr}; pg8::gemm_phase<pg8::EpiResid<true>, pg8::StaticOrder, true, true>(lds, g, So, E); }
            }
            xcd_barrier(bar);
        }
    }
}

extern "C" void kernel_launch(void* const* d_in, const int* in_sizes, int n_in, void* d_out, int out_size, void* d_ws, size_t ws_size, hipStream_t stream) {
    static int grid = 0;
    if (grid == 0) {
        if (n_in != 17 || ws_size < WS_END) { fprintf(stderr, "kernel_launch: unexpected n_in %d / ws_size %zu\n", n_in, ws_size); grid = -1; return; }
        int dev = 0, cus = 0, per_cu = 0;
        hipGetDevice(&dev); hipDeviceGetAttribute(&cus, hipDeviceAttributeMultiprocessorCount, dev);
        if (hipFuncSetAttribute((const void*)fwd_megakernel, hipFuncAttributeMaxDynamicSharedMemorySize, LDS_BYTES) != hipSuccess) { fprintf(stderr, "kernel_launch: hipFuncSetAttribute failed\n"); grid = -1; return; }
        if (hipOccupancyMaxActiveBlocksPerMultiprocessor(&per_cu, (const void*)fwd_megakernel, 512, LDS_BYTES) != hipSuccess || per_cu < 1) { fprintf(stderr, "kernel_launch: occupancy query says %d\n", per_cu); per_cu = 1; }
        (void)hipGetLastError();
        grid = cus;
    }
    if (grid < 0) return;
    if (hipMemsetAsync((char*)d_ws + WS_BAR, 0, 16384, stream) != hipSuccess) { fprintf(stderr, "kernel_launch: memset of the barrier words failed\n"); return; }
    Args a{};
    for (int i = 0; i < 17; ++i) a.in[i] = (const float*)d_in[i];
    a.out = (float*)d_out; a.ws = (unsigned char*)d_ws;
    void* args[] = {&a};
    hipError_t e = hipLaunchCooperativeKernel((const void*)fwd_megakernel, dim3(grid), dim3(512), args, LDS_BYTES, stream);
    if (e != hipSuccess) fprintf(stderr, "cooperative launch failed: %s (grid %d)\n", hipGetErrorString(e), grid);
}
```

```cpp
#include <hip/hip_runtime.h>
#include <hip/hip_cooperative_groups.h>
#include <cstdio>
#include <cstdint>
namespace cg = cooperative_groups;

#define EPS_F 1e-6f
__device__ __forceinline__ int ltid() { int t = threadIdx.x; asm volatile("" : "+v"(t)); return t; }
namespace pg8 {
#define PG8_LAS __attribute__((address_space(3)))
typedef unsigned short bf16_t;
typedef short bf16x8 __attribute__((ext_vector_type(8)));
typedef float f32x4 __attribute__((ext_vector_type(4)));
typedef unsigned u32x4 __attribute__((ext_vector_type(4)));
constexpr int BM = 256, BK = 64, HALF = 128, HTB = HALF * BK * 2  , STAGE_BYTES = 8 * HTB, NXCD = 8, WGM = 8;

__host__ __device__ __forceinline__ int lds_byte(int r, int c) { const int st = (r >> 4) * 2 + (c >> 5), rr = r & 15, cc = c & 31, ob = rr * 64 + cc * 2; return st * 1024 + (ob ^ (((ob >> 9) & 1) << 5)); }
__host__ __device__ __forceinline__ void stage_rc(int b, int& R, int& C) { const int st = b / 1024, sb = b % 1024, swz = sb ^ (((sb >> 9) & 1) << 5); R = (st >> 1) * 16 + swz / 64; C = (st & 1) * 32 + (swz % 64) / 2; }
__host__ __device__ __forceinline__ int perm32(int rho) { const int n = rho >> 4, i = rho & 15; return 8 * (i >> 2) + 4 * n + (i & 3); }

struct Unit { int pm, pn, koff, part, ord; };
struct Gemm { const bf16_t* A; const bf16_t* Bt; int M, N, K, ld; };

struct StaticOrder {
    int nM, nN, nwg, G, c;
    __host__ __device__ void init(int M, int N, int G_, int c_) { nM = M / BM; nN = N / BM; nwg = nM * nN; G = G_; c = c_; }
    __host__ __device__ bool next(int i, Unit& u) const {
        const long L = (long)i * G + c; if (L >= nwg) return false;
        int wgid = (int)L; { const int q = nwg / NXCD, r = nwg % NXCD, xcd = wgid % NXCD, off = wgid / NXCD; wgid = (xcd < r ? xcd * (q + 1) : r * (q + 1) + (xcd - r) * q) + off; }
        const int nig = WGM * nN, gid = wgid / nig, fm = gid * WGM, gsz = (nM - fm) < WGM ? (nM - fm) : WGM;
        u.pm = fm + ((wgid % nig) % gsz); u.pn = (wgid % nig) / gsz; u.koff = 0; u.part = 1; u.ord = i; return true;
    }
    __device__ __forceinline__ void a_ready(const Unit&) const {}
    __device__ __forceinline__ void done(const Unit&) const {}
};

struct PairOrder {
    StaticOrder so; int kpart;
    __host__ __device__ void init(int M, int N, int G_, int c_, int kpart_) { so.init(M, N, G_, c_); kpart = kpart_; }
    __host__ __device__ bool next(int i, Unit& u) const { if (!so.next(i >> 1, u)) return false; u.ord = i >> 1; u.part = i & 1; u.koff = (i & 1) * kpart; return true; }
    __device__ __forceinline__ void a_ready(const Unit&) const {}
    __device__ __forceinline__ void done(const Unit&) const {}
};
typedef unsigned u32x2 __attribute__((ext_vector_type(2)));
typedef float f32x2_t __attribute__((ext_vector_type(2))); typedef __bf16 bf16x2_t __attribute__((ext_vector_type(2)));
__device__ __forceinline__ unsigned cvt_pk_bf16(float lo, float hi) { f32x2_t v = {lo, hi}; bf16x2_t b = __builtin_convertvector(v, bf16x2_t); return __builtin_bit_cast(unsigned, b); }
__device__ __forceinline__ u32x2 pk4(f32x4 v) { u32x2 w; w.x = cvt_pk_bf16(v[0], v[1]); w.y = cvt_pk_bf16(v[2], v[3]); return w; }
__device__ __forceinline__ bf16_t bf1(float v) { return (bf16_t)(cvt_pk_bf16(v, v) & 0xffffu); }
__device__ __forceinline__ f32x4 unpk4(u32x2 w) { f32x4 v; v[0] = __uint_as_float(w.x << 16); v[1] = __uint_as_float(w.x & 0xffff0000u); v[2] = __uint_as_float(w.y << 16); v[3] = __uint_as_float(w.y & 0xffff0000u); return v; }
__device__ __forceinline__ float row_rstd(const float* ss, int t) {
    const f32x4* sp = (const f32x4*)(ss + (size_t)t * 16);
    const f32x4 a0 = sp[0], a1 = sp[1], a2 = sp[2], a3 = sp[3];
    const float tot = (((a0[0] + a0[1]) + (a0[2] + a0[3])) + ((a1[0] + a1[1]) + (a1[2] + a1[3]))) + (((a2[0] + a2[1]) + (a2[2] + a2[3])) + ((a3[0] + a3[1]) + (a3[2] + a3[3])));
    return rsqrtf(tot * (1.0f / 1024.0f) + EPS_F);
}

typedef float f32x2 __attribute__((ext_vector_type(2)));
__device__ __forceinline__ f32x2 gelu_pk(f32x2 v) {
    const f32x2 av = __builtin_elementwise_abs(v), d = av * 0.2316418882f + 1.0f;
    f32x2 t; t.x = __builtin_amdgcn_rcpf(d.x); t.y = __builtin_amdgcn_rcpf(d.y);
    f32x2 q = t * 0.5307027145f + (-0.7265760135f); q = q * t + 0.7107068705f; q = q * t + (-0.142248368f); q = q * t + 0.127414796f; q = q * t;
    const f32x2 s = (v * v) * (-0.72134752044f);
    f32x2 e; e.x = __builtin_amdgcn_exp2f(s.x); e.y = __builtin_amdgcn_exp2f(s.y);
    const f32x2 m = v * (q * e), r = v - m;
    f32x2 o; o.x = v.x < 0.f ? m.x : r.x; o.y = v.y < 0.f ? m.y : r.y; return o;
}

typedef __attribute__((address_space(3))) const float lds_cf;
__device__ __forceinline__ void rows_rstd(lds_cf* rt, int ord, int wr, int fr, float (&rs)[2][4]) {
#pragma unroll
    for (int ai = 0; ai < 2; ++ai)
#pragma unroll
        for (int m = 0; m < 4; ++m) rs[ai][m] = rt[ord * BM + ai * HALF + wr * 64 + m * 16 + fr];
}
template <class Sched> __device__ __forceinline__ void rstd_table(const float* ss, const Sched& S, __attribute__((address_space(3))) float* rt) {
    const int tid = ltid(), half = tid >> 8, row = tid & 255;
    Unit u;
    for (int i = half; S.next(i, u); i += 2) {
        const f32x4* sp = (const f32x4*)(ss + (size_t)(u.pm * BM + row) * 16);
        const f32x4 s4 = (sp[0] + sp[1]) + (sp[2] + sp[3]);
        rt[i * BM + row] = rsqrtf(((s4[0] + s4[1]) + (s4[2] + s4[3])) * (1.0f / 1024.0f) + EPS_F);
    }
    __syncthreads();
}

struct EpiIn {
    static constexpr bool PERM = false, AFTER_DRAIN = false;
    lds_cf* rt; const float* gq; const float* gk; const float* bgate; const float* dec2;
    bf16_t *Qa, *Ka, *Vat, *Qr, *Kr, *Ktf, *Ktb, *Vrt, *Gr, *Gates;
    int S, sshift;
    __device__ __forceinline__ void operator()(const f32x4 (&acc)[2][2][4][2], const Unit& u, int wr, int wc, int fr, int fq) const {
        asm volatile("" : "+v"(fr), "+v"(fq));
        const int pn = (u.pn == 2) ? 4 : (u.pn == 4) ? 2 : (u.pn == 5) ? 10 : (u.pn == 10) ? 5 : u.pn;
        const int t00 = u.pm * BM + wr * 64 + fr;
        float rs[2][4];
        rows_rstd(rt, u.ord, wr, fr, rs);
        float lf2 = 0.f, lb2 = 0.f;
        f32x4 g4[2][2], b4[2][2];
        const bool do_norm = (pn <= 1) || (pn == 2 && wc < 2);
        if (pn == 4) { lf2 = dec2[wc]; lb2 = dec2[4 + wc]; }
        if (do_norm) { const float* gg = (pn <= 1) ? gq : gk;
#pragma unroll
            for (int bj = 0; bj < 2; ++bj)
#pragma unroll
                for (int n = 0; n < 2; ++n) g4[bj][n] = *(const f32x4*)(gg + 32 * bj + 16 * n + 4 * fq); }
        if (pn >= 9) {
#pragma unroll
            for (int bj = 0; bj < 2; ++bj)
#pragma unroll
                for (int n = 0; n < 2; ++n) b4[bj][n] = *(const f32x4*)(bgate + 256 * (pn - 9) + 32 * wc + 4 * fq + 128 * bj + 16 * n); }
        f32x4 frev;
#pragma unroll
        for (int e = 0; e < 4; ++e) frev[e] = __builtin_amdgcn_exp2f(-(float)(4 * fq + e) * 0.8304820237218406f) * 0.15915494309189535f;
#pragma unroll
        for (int ai = 0; ai < 2; ++ai)
#pragma unroll
            for (int m = 0; m < 4; ++m) {
                const int t = t00 + ai * HALF + m * 16;
                const float rstd = rs[ai][m];
                f32x4 v[2][2];
#pragma unroll
                for (int bj = 0; bj < 2; ++bj)
#pragma unroll
                    for (int n = 0; n < 2; ++n) v[bj][n] = acc[ai][bj][m][n] * rstd;
                const int s = t & (S - 1), seq = t >> sshift;
                if (pn <= 4) {
                    const bool isv = (pn == 2) && (wc >= 2);
                    if (do_norm) {
                        float q = 0.f;
#pragma unroll
                        for (int bj = 0; bj < 2; ++bj)
#pragma unroll
                            for (int n = 0; n < 2; ++n) { const f32x4 x = v[bj][n]; q += (x[0] * x[0] + x[1] * x[1]) + (x[2] * x[2] + x[3] * x[3]); }
                        q += __shfl_xor(q, 16); q += __shfl_xor(q, 32);
                        const float inv = rsqrtf(q * (1.0f / 64.0f) + EPS_F);
#pragma unroll
                        for (int bj = 0; bj < 2; ++bj)
#pragma unroll
                            for (int n = 0; n < 2; ++n) v[bj][n] = v[bj][n] * inv * g4[bj][n];
                    }
                    if (!isv) {
#pragma unroll
                        for (int bj = 0; bj < 2; ++bj) {
                            const float pos = (float)((bj == 0) ? (s >> 6) : (s & 63));
                            f32x4 c, sn;
#pragma unroll
                            for (int e = 0; e < 4; ++e) { float rev = pos * frev[e]; rev = rev - floorf(rev); c[e] = __builtin_amdgcn_cosf(rev); sn[e] = __builtin_amdgcn_sinf(rev); }
                            const f32x4 x1 = v[bj][0], x2 = v[bj][1];
                            v[bj][0] = x1 * c - x2 * sn; v[bj][1] = x2 * c + x1 * sn;
                        }
                    }
                    if (pn <= 1) {
                        bf16_t* dst = Qa + (size_t)t * 512 + (4 * pn + wc) * 64 + 4 * fq;
#pragma unroll
                        for (int bj = 0; bj < 2; ++bj)
#pragma unroll
                            for (int n = 0; n < 2; ++n) *(u32x2*)(dst + 32 * bj + 16 * n) = pk4(v[bj][n] * 0.18033688011112042f);
                    } else if (pn == 2) {
                        if (wc < 2) {
                            bf16_t* dst = Ka + (size_t)t * 128 + wc * 64 + 4 * fq;
#pragma unroll
                            for (int bj = 0; bj < 2; ++bj)
#pragma unroll
                                for (int n = 0; n < 2; ++n) *(u32x2*)(dst + 32 * bj + 16 * n) = pk4(v[bj][n]);
                        } else {
                            bf16_t* dst = Vat + ((size_t)(seq * 2 + (wc - 2)) * 64 + 4 * fq) * S + s;
#pragma unroll
                            for (int bj = 0; bj < 2; ++bj)
#pragma unroll
                                for (int n = 0; n < 2; ++n)
#pragma unroll
                                    for (int e = 0; e < 4; ++e) dst[(size_t)(32 * bj + 16 * n + e) * S] = bf1(v[bj][n][e]);
                        }
                    } else if (pn == 3) {
                        bf16_t* dst = Qr + (size_t)t * 256 + wc * 64 + 4 * fq;
#pragma unroll
                        for (int bj = 0; bj < 2; ++bj)
#pragma unroll
                            for (int n = 0; n < 2; ++n) *(u32x2*)(dst + 32 * bj + 16 * n) = pk4(v[bj][n]);
                    } else {
                        const int pc = s & 127;
                        const float df = __builtin_amdgcn_exp2f(lf2 * (float)(127 - pc)) * 0.125f, db = __builtin_amdgcn_exp2f(lb2 * (float)pc) * 0.125f;
                        bf16_t* dst = Kr + (size_t)t * 256 + wc * 64 + 4 * fq;
                        const size_t toff = ((size_t)(seq * 4 + wc) * 64 + 4 * fq) * S + s;
#pragma unroll
                        for (int bj = 0; bj < 2; ++bj)
#pragma unroll
                            for (int n = 0; n < 2; ++n) {
                                *(u32x2*)(dst + 32 * bj + 16 * n) = pk4(v[bj][n] * 0.125f);
#pragma unroll
                                for (int e = 0; e < 4; ++e) { const size_t o = toff + (size_t)(32 * bj + 16 * n + e) * S; Ktf[o] = bf1(v[bj][n][e] * df); Ktb[o] = bf1(v[bj][n][e] * db); }
                            }
                    }
                } else if (pn <= 6) {
#pragma unroll
                    for (int bj = 0; bj < 2; ++bj) {
                        bf16_t* dst = Vrt + ((size_t)(seq * 4 + 2 * (pn - 5) + bj) * 128 + 32 * wc + 4 * fq) * S + s;
#pragma unroll
                        for (int n = 0; n < 2; ++n)
#pragma unroll
                            for (int e = 0; e < 4; ++e) dst[(size_t)(16 * n + e) * S] = bf1(v[bj][n][e]);
                    }
                } else if (pn <= 8) {
                    bf16_t* dst = Gr + (size_t)t * 512 + 256 * (pn - 7) + 32 * wc + 4 * fq;
#pragma unroll
                    for (int bj = 0; bj < 2; ++bj)
#pragma unroll
                        for (int n = 0; n < 2; ++n) { f32x4 x = v[bj][n];
#pragma unroll
                            for (int e = 0; e < 4; ++e) x[e] = x[e] * __builtin_amdgcn_rcpf(1.0f + __builtin_amdgcn_exp2f(-1.4426950408889634f * x[e]));
                            *(u32x2*)(dst + 128 * bj + 16 * n) = pk4(x); }
                } else {
                    bf16_t* dst = Gates + (size_t)t * 2048 + 256 * (pn - 9) + 32 * wc + 4 * fq;
#pragma unroll
                    for (int bj = 0; bj < 2; ++bj)
#pragma unroll
                        for (int n = 0; n < 2; ++n) { f32x4 x = v[bj][n] + b4[bj][n];
#pragma unroll
                            for (int e = 0; e < 4; ++e) x[e] = __builtin_amdgcn_rcpf(1.0f + __builtin_amdgcn_exp2f(-1.4426950408889634f * x[e]));
                            *(u32x2*)(dst + 128 * bj + 16 * n) = pk4(x); }
                }
            }
    }
};

struct EpiMergeF {
    static constexpr bool PERM = false, AFTER_DRAIN = false;
    const bf16_t* Gates; bf16_t* Mg;
    __device__ __forceinline__ void operator()(f32x4 (&acc)[2][2][4][2], const Unit& u, int wr, int wc, int fr, int fq) const {
        asm volatile("" : "+v"(fr), "+v"(fq));
        const int t00 = u.pm * BM + wr * 64 + fr, c0 = u.pn * BM + 32 * wc + 4 * fq;
        if (u.part == 0) {
#pragma unroll
            for (int ai = 0; ai < 2; ++ai) {
                u32x2 ga[4][2][2], gr[4][2][2];
#pragma unroll
                for (int m = 0; m < 4; ++m)
#pragma unroll
                    for (int bj = 0; bj < 2; ++bj)
#pragma unroll
                        for (int n = 0; n < 2; ++n) { const bf16_t* gp = Gates + (size_t)(t00 + ai * HALF + m * 16) * 2048 + c0 + 128 * bj + 16 * n; ga[m][bj][n] = *(const u32x2*)gp; gr[m][bj][n] = *(const u32x2*)(gp + 1024); }
#pragma unroll
                for (int m = 0; m < 4; ++m)
#pragma unroll
                    for (int bj = 0; bj < 2; ++bj)
#pragma unroll
                        for (int n = 0; n < 2; ++n) { const f32x4 a4 = unpk4(ga[m][bj][n]), r4 = unpk4(gr[m][bj][n]); f32x4 r = acc[ai][bj][m][n];
#pragma unroll
                            for (int e = 0; e < 4; ++e) r[e] *= a4[e] * __builtin_amdgcn_rcpf(r4[e]);
                            acc[ai][bj][m][n] = r; }
            }
        } else {
            u32x2 gr[2][4][2][2];
#pragma unroll
            for (int ai = 0; ai < 2; ++ai)
#pragma unroll
                for (int m = 0; m < 4; ++m)
#pragma unroll
                    for (int bj = 0; bj < 2; ++bj)
#pragma unroll
                        for (int n = 0; n < 2; ++n) gr[ai][m][bj][n] = *(const u32x2*)(Gates + (size_t)(t00 + ai * HALF + m * 16) * 2048 + 1024 + c0 + 128 * bj + 16 * n);
#pragma unroll
            for (int ai = 0; ai < 2; ++ai)
#pragma unroll
                for (int m = 0; m < 4; ++m)
#pragma unroll
                    for (int bj = 0; bj < 2; ++bj)
#pragma unroll
                        for (int n = 0; n < 2; ++n) *(u32x2*)(Mg + (size_t)(t00 + ai * HALF + m * 16) * 1024 + c0 + 128 * bj + 16 * n) = pk4(acc[ai][bj][m][n] * unpk4(gr[ai][m][bj][n]));
        }
    }
};

template <bool FINAL> struct EpiResid {
    static constexpr bool PERM = false, AFTER_DRAIN = false;
    bf16_t* xb; float* out; float* ss;
    __device__ __forceinline__ void operator()(f32x4 (&acc)[2][2][4][2], const Unit& u, int wr, int wc, int fr, int fq) const {
        asm volatile("" : "+v"(fr), "+v"(fq));
        const int t00 = u.pm * BM + wr * 64 + fr, c0 = u.pn * BM + 32 * wc + 4 * fq;
        u32x2 xo[4][2][2];
#define RES_LOAD(ai) _Pragma("unroll") for (int m = 0; m < 4; ++m) _Pragma("unroll") for (int bj = 0; bj < 2; ++bj) _Pragma("unroll") for (int n = 0; n < 2; ++n) \
            xo[m][bj][n] = *(const u32x2*)(xb + (size_t)(t00 + (ai) * HALF + m * 16) * 1024 + c0 + 128 * bj + 16 * n);
#define RES_ADD(ai) _Pragma("unroll") for (int m = 0; m < 4; ++m) _Pragma("unroll") for (int bj = 0; bj < 2; ++bj) _Pragma("unroll") for (int n = 0; n < 2; ++n) acc[ai][bj][m][n] += unpk4(xo[m][bj][n]);
#define RES_STORE(ai) _Pragma("unroll") for (int m = 0; m < 4; ++m) { const int t = t00 + (ai) * HALF + m * 16; float q = 0.f; \
            _Pragma("unroll") for (int bj = 0; bj < 2; ++bj) _Pragma("unroll") for (int n = 0; n < 2; ++n) { const size_t o = (size_t)t * 1024 + c0 + 128 * bj + 16 * n; const f32x4 x = acc[ai][bj][m][n]; \
                if (FINAL) *(f32x4*)(out + o) = x; else { *(u32x2*)(xb + o) = pk4(x); q += (x[0] * x[0] + x[1] * x[1]) + (x[2] * x[2] + x[3] * x[3]); } } \
            if (!FINAL) { q += __shfl_xor(q, 16); q += __shfl_xor(q, 32); if (fq == 0) ss[(size_t)t * 16 + u.pn * 4 + wc] = q; } }
        RES_LOAD(0) RES_ADD(0) RES_LOAD(1) RES_STORE(0) RES_ADD(1) RES_STORE(1)
#undef RES_LOAD
#undef RES_ADD
#undef RES_STORE
    }
};

template <int CTRL> __device__ __forceinline__ float dpp_f(float v) { int iv = __builtin_bit_cast(int, v); asm volatile("" : "+v"(iv)); int r = __builtin_amdgcn_update_dpp(0, iv, CTRL, 0xF, 0xF, false); asm volatile("" : "+v"(r)); return __builtin_bit_cast(float, r); }
__device__ __forceinline__ f32x4 dpp_ror1(f32x4 v) { f32x4 r; r[0] = dpp_f<0x121>(v[0]); r[1] = dpp_f<0x121>(v[1]); r[2] = dpp_f<0x121>(v[2]); r[3] = dpp_f<0x121>(v[3]); return r; }
__device__ __forceinline__ f32x4 dpp_ror15(f32x4 v) { f32x4 r; r[0] = dpp_f<0x12F>(v[0]); r[1] = dpp_f<0x12F>(v[1]); r[2] = dpp_f<0x12F>(v[2]); r[3] = dpp_f<0x12F>(v[3]); return r; }
typedef __attribute__((address_space(3))) float lds_f;
struct EpiUpConv {
    static constexpr bool PERM = false, AFTER_DRAIN = false;
    lds_cf* rt; lds_f* xch; const float* cw; const float* cb; bf16_t* ACT; bf16_t* Uedge;
    __device__ __forceinline__ void operator()(f32x4 (&acc)[2][2][4][2], const Unit& u, int wr, int wc, int fr, int fq) const {
        asm volatile("" : "+v"(fr), "+v"(fq));
        float rs[2][4];
        rows_rstd(rt, u.ord, wr, fr, rs);
#pragma unroll
        for (int ai = 0; ai < 2; ++ai)
#pragma unroll
            for (int bj = 0; bj < 2; ++bj)
#pragma unroll
                for (int m = 0; m < 4; ++m)
#pragma unroll
                    for (int n = 0; n < 2; ++n) acc[ai][bj][m][n] *= rs[ai][m];
        lds_f* xb_ = xch + (u.ord & 1) * 2048 + wc * 512;
        if (fr == 0) {
#pragma unroll
            for (int ai = 0; ai < 2; ++ai)
#pragma unroll
                for (int bj = 0; bj < 2; ++bj)
#pragma unroll
                    for (int n = 0; n < 2; ++n) *(__attribute__((address_space(3))) f32x4*)(xb_ + ((2 * ai + wr) * 2 + 0) * 64 + (bj * 2 + n) * 16 + fq * 4) = acc[ai][bj][0][n];
        }
        if (fr == 15) {
#pragma unroll
            for (int ai = 0; ai < 2; ++ai)
#pragma unroll
                for (int bj = 0; bj < 2; ++bj)
#pragma unroll
                    for (int n = 0; n < 2; ++n) *(__attribute__((address_space(3))) f32x4*)(xb_ + ((2 * ai + wr) * 2 + 1) * 64 + (bj * 2 + n) * 16 + fq * 4) = acc[ai][bj][3][n];
        }
        if (wr == 0 && fr < 2) {
            bf16_t* dst = Uedge + ((size_t)u.pm * 4 + fr) * 5632 + u.pn * BM + 32 * wc + 4 * fq;
#pragma unroll
            for (int bj = 0; bj < 2; ++bj)
#pragma unroll
                for (int n = 0; n < 2; ++n) *(u32x2*)(dst + 128 * bj + 16 * n) = pk4(acc[0][bj][0][n]);
        }
        if (wr == 1 && fr >= 14) {
            bf16_t* dst = Uedge + ((size_t)u.pm * 4 + 2 + (fr - 14)) * 5632 + u.pn * BM + 32 * wc + 4 * fq;
#pragma unroll
            for (int bj = 0; bj < 2; ++bj)
#pragma unroll
                for (int n = 0; n < 2; ++n) *(u32x2*)(dst + 128 * bj + 16 * n) = pk4(acc[1][bj][3][n]);
        }
        asm volatile("s_waitcnt lgkmcnt(0)" ::: "memory"); __builtin_amdgcn_s_barrier(); asm volatile("" ::: "memory");
#pragma unroll
        for (int n = 0; n < 2; ++n) {
            const int v0 = u.pn * 128 + 32 * wc + 16 * n + 4 * fq;
            f32x4 w[2][3], bb[2];
#pragma unroll
            for (int bj = 0; bj < 2; ++bj) {
#pragma unroll
                for (int k = 0; k < 3; ++k) w[bj][k] = *(const f32x4*)(cw + k * 5632 + bj * 2816 + v0);
                bb[bj] = *(const f32x4*)(cb + bj * 2816 + v0);
            }
#pragma unroll
            for (int ai = 0; ai < 2; ++ai) {
                const int blk = 2 * ai + wr;
                f32x4 P[2], N[2];
#pragma unroll
                for (int bj = 0; bj < 2; ++bj) {
                    P[bj] = (blk > 0) ? *(const __attribute__((address_space(3))) f32x4*)(xb_ + ((blk - 1) * 2 + 1) * 64 + (bj * 2 + n) * 16 + fq * 4) : (f32x4){0.f, 0.f, 0.f, 0.f};
                    N[bj] = (blk < 3) ? *(const __attribute__((address_space(3))) f32x4*)(xb_ + ((blk + 1) * 2 + 0) * 64 + (bj * 2 + n) * 16 + fq * 4) : (f32x4){0.f, 0.f, 0.f, 0.f};
                }
#pragma unroll
                for (int m = 0; m < 4; ++m) {
                    f32x4 y[2];
#pragma unroll
                    for (int bj = 0; bj < 2; ++bj) {
                        const f32x4 x = acc[ai][bj][m][n];
                        const f32x4 rp = dpp_ror1(x), rn = dpp_ror15(x);
                        const f32x4 sp = (m > 0) ? dpp_ror1(acc[ai][bj][m > 0 ? m - 1 : 0][n]) : P[bj];
                        const f32x4 sn = (m < 3) ? dpp_ror15(acc[ai][bj][m < 3 ? m + 1 : 3][n]) : N[bj];
                        f32x4 pv, nv;
#pragma unroll
                        for (int e = 0; e < 4; ++e) { pv[e] = (fr == 0) ? sp[e] : rp[e]; nv[e] = (fr == 15) ? sn[e] : rn[e]; }
                        y[bj] = w[bj][0] * pv + w[bj][1] * x + w[bj][2] * nv + bb[bj];
                    }
                    const f32x2 g0 = gelu_pk((f32x2){y[1][0], y[1][1]}), g1 = gelu_pk((f32x2){y[1][2], y[1][3]});
                    const f32x4 o = {g0.x * y[0][0], g0.y * y[0][1], g1.x * y[0][2], g1.y * y[0][3]};
                    const int trow = ai * HALF + wr * 64 + m * 16 + fr;
                    if (trow != 0 && trow != 255) *(u32x2*)(ACT + (size_t)(u.pm * BM + trow) * 2816 + v0) = pk4(o);
                }
            }
        }
    }
};

template <class Epi, class Sched, bool ALIGN_EPI = false, bool SP2 = false>
__device__ __forceinline__ void gemm_phase(PG8_LAS unsigned char* lds, const Gemm g, const Sched& S, const Epi& E) {
    const int tid = ltid(), wid = __builtin_amdgcn_readfirstlane(tid >> 6), lane = tid & 63, wr = wid >> 2, wc = wid & 3, fr = lane & 15, fq = lane >> 4;
    const int K = g.K, LD = g.ld, nt = K / BK;
    unsigned voffA[2], voffB[2];
#pragma unroll
    for (int i = 0; i < 2; ++i) { int R, C; stage_rc(tid * 16 + i * 8192, R, C); const int Rb = Epi::PERM ? ((R & ~31) + perm32(R & 31)) : R;
        voffA[i] = (unsigned)(R * LD + C) * 2u; voffB[i] = (unsigned)(Rb * LD + C) * 2u; }
    const size_t kstep = (size_t)(BK * 2);
    const size_t hstep = (size_t)HALF * LD * 2;
    const size_t tstep = 2 * hstep;
    const unsigned ldsw = (unsigned)wid * 1024u;
    const int aoff = lds_byte(wr * 64 + fr, fq * 8), boff = lds_byte(wc * 32 + fr, fq * 8);
#define PG8_SA(b, h) (((b) * 2 + (h)) * HTB)
#define PG8_SB(b, h) ((4 + (b) * 2 + (h)) * HTB)
#define PG8_STAGE(bufoff, gbase, voff) do { _Pragma("unroll") for (int _i = 0; _i < 2; ++_i) \
        __builtin_amdgcn_global_load_lds((const unsigned*)((const char*)(gbase) + (voff)[_i]), (PG8_LAS unsigned*)(lds + (bufoff) + ldsw + _i * 8192), 16, 0, 0); } while (0)
#define PG8_LDA(dst, b, h) do { _Pragma("unroll") for (int m = 0; m < 4; ++m) _Pragma("unroll") for (int k = 0; k < 2; ++k) dst[m][k] = *(const PG8_LAS bf16x8*)(lds + PG8_SA(b, h) + aoff + m * 2048 + k * 1024); } while (0)
#define PG8_LDB(dst, b, h) do { _Pragma("unroll") for (int n = 0; n < 2; ++n) _Pragma("unroll") for (int k = 0; k < 2; ++k) dst[n][k] = *(const PG8_LAS bf16x8*)(lds + PG8_SB(b, h) + boff + n * 2048 + k * 1024); } while (0)
#define PG8_MMA(ai, bj, At, Bt) do { __builtin_amdgcn_s_setprio(1); _Pragma("unroll") for (int m = 0; m < 4; ++m) _Pragma("unroll") for (int n = 0; n < 2; ++n) _Pragma("unroll") for (int k = 0; k < 2; ++k) \
        acc[ai][bj][m][n] = __builtin_amdgcn_mfma_f32_16x16x32_bf16(Bt[n][k], At[m][k], acc[ai][bj][m][n], 0, 0, 0); __builtin_amdgcn_s_setprio(0); } while (0)
#define PG8_WAIT_V(n) asm volatile("s_waitcnt vmcnt(" #n ")" ::: "memory")
#define PG8_WAIT_L(n) asm volatile("s_waitcnt lgkmcnt(" #n ")" ::: "memory")
#define PG8_BAR __builtin_amdgcn_s_barrier()
#define PG8_SCHED __builtin_amdgcn_sched_barrier(0)
    Unit cur, nxt; int ui = 0;
    if (!S.next(0, cur)) return;
    f32x4 acc[2][2][4][2];
#pragma unroll
    for (int a = 0; a < 2; ++a)
#pragma unroll
        for (int b = 0; b < 2; ++b)
#pragma unroll
            for (int m = 0; m < 4; ++m)
#pragma unroll
                for (int n = 0; n < 2; ++n) acc[a][b][m][n] = (f32x4){0.f, 0.f, 0.f, 0.f};
    bf16x8 At[4][2], B0[2][2], B1[2][2];
    const char* cA = (const char*)g.A + (size_t)cur.pm * tstep + (size_t)cur.koff * 2; const char* cB = (const char*)g.Bt + (size_t)cur.pn * tstep + (size_t)cur.koff * 2;
    S.a_ready(cur);
    if constexpr (SP2) {
        PG8_STAGE(PG8_SB(0, 0), cB, voffB); PG8_STAGE(PG8_SB(0, 1), cB + hstep, voffB); PG8_STAGE(PG8_SA(0, 0), cA, voffA); PG8_STAGE(PG8_SA(0, 1), cA + hstep, voffA);
        if (wr == 1) PG8_BAR;
        PG8_WAIT_V(2); PG8_BAR;
        PG8_STAGE(PG8_SB(1, 0), cB + kstep, voffB); PG8_STAGE(PG8_SA(1, 0), cA + kstep, voffA); PG8_STAGE(PG8_SB(1, 1), cB + hstep + kstep, voffB);
        PG8_WAIT_V(6); PG8_BAR;
    } else {
        PG8_STAGE(PG8_SB(0, 0), cB, voffB); PG8_STAGE(PG8_SA(0, 0), cA, voffA); PG8_STAGE(PG8_SB(0, 1), cB + hstep, voffB); PG8_STAGE(PG8_SA(0, 1), cA + hstep, voffA);
        if (wr == 1) PG8_BAR;
        PG8_WAIT_V(4); PG8_BAR;
        PG8_STAGE(PG8_SB(1, 0), cB + kstep, voffB); PG8_STAGE(PG8_SA(1, 0), cA + kstep, voffA); PG8_STAGE(PG8_SB(1, 1), cB + hstep + kstep, voffB);
        PG8_WAIT_V(6); PG8_BAR;
    }
    for (;;) {
        const bool has_next = S.next(ui + 1, nxt);
        const char* nA = has_next ? (const char*)g.A + (size_t)nxt.pm * tstep + (size_t)nxt.koff * 2 : cA; const char* nB = has_next ? (const char*)g.Bt + (size_t)nxt.pn * tstep + (size_t)nxt.koff * 2 : cB;
        for (int t = 0; t < nt; t += 2) {
            const bool last = (t == nt - 2);
            const char* a1 = cA + (size_t)(t + 1) * kstep;
            const char* a2 = last ? nA : cA + (size_t)(t + 2) * kstep; const char* b2 = last ? nB : cB + (size_t)(t + 2) * kstep;
            const char* a3 = a2 + kstep; const char* b3 = b2 + kstep;
            if (last && has_next) S.a_ready(nxt);
            if constexpr (SP2) {
            PG8_LDB(B0, 0, 0); PG8_LDB(B1, 0, 1); PG8_SCHED; PG8_LDA(At, 0, 0); PG8_STAGE(PG8_SA(1, 1), a1 + hstep, voffA);
            PG8_WAIT_V(8); PG8_WAIT_L(0); PG8_BAR; PG8_MMA(0, 0, At, B0); PG8_MMA(0, 1, At, B1); PG8_BAR; PG8_SCHED;
            PG8_LDA(At, 0, 1); PG8_STAGE(PG8_SB(0, 0), b2, voffB); PG8_STAGE(PG8_SB(0, 1), b2 + hstep, voffB); PG8_STAGE(PG8_SA(0, 0), a2, voffA);
            PG8_WAIT_V(8); PG8_WAIT_L(0); PG8_BAR; PG8_MMA(1, 0, At, B0); PG8_MMA(1, 1, At, B1); PG8_BAR; PG8_SCHED;
            PG8_LDB(B0, 1, 0); PG8_LDB(B1, 1, 1); PG8_SCHED; PG8_LDA(At, 1, 0); PG8_STAGE(PG8_SA(0, 1), a2 + hstep, voffA);
            PG8_WAIT_V(8); PG8_WAIT_L(0); PG8_BAR; PG8_MMA(0, 0, At, B0); PG8_MMA(0, 1, At, B1); PG8_BAR; PG8_SCHED;
            PG8_LDA(At, 1, 1); PG8_STAGE(PG8_SB(1, 0), b3, voffB); PG8_STAGE(PG8_SB(1, 1), b3 + hstep, voffB); PG8_STAGE(PG8_SA(1, 0), a3, voffA);
            PG8_WAIT_V(8); PG8_WAIT_L(0); PG8_BAR; PG8_MMA(1, 0, At, B0); PG8_MMA(1, 1, At, B1); PG8_BAR; PG8_SCHED;
            } else {
            PG8_LDB(B0, 0, 0); PG8_SCHED; PG8_LDA(At, 0, 0); PG8_STAGE(PG8_SA(1, 1), a1 + hstep, voffA);
            PG8_WAIT_L(8); PG8_BAR; PG8_WAIT_L(0); PG8_MMA(0, 0, At, B0); PG8_BAR; PG8_SCHED;
            PG8_LDB(B1, 0, 1); PG8_STAGE(PG8_SB(0, 0), b2, voffB);
            PG8_BAR; PG8_WAIT_L(0); PG8_MMA(0, 1, At, B1); PG8_BAR;
            PG8_LDA(At, 0, 1); PG8_STAGE(PG8_SA(0, 0), a2, voffA);
            PG8_BAR; PG8_WAIT_L(0); PG8_MMA(1, 0, At, B0); PG8_BAR; PG8_SCHED;
            PG8_STAGE(PG8_SB(0, 1), b2 + hstep, voffB);
            PG8_WAIT_V(6); PG8_BAR; PG8_MMA(1, 1, At, B1); PG8_BAR;
            PG8_LDB(B0, 1, 0); PG8_SCHED; PG8_LDA(At, 1, 0); PG8_STAGE(PG8_SA(0, 1), a2 + hstep, voffA);
            PG8_WAIT_L(8); PG8_BAR; PG8_WAIT_L(0); PG8_MMA(0, 0, At, B0); PG8_BAR; PG8_SCHED;
            PG8_LDB(B1, 1, 1); PG8_STAGE(PG8_SB(1, 0), b3, voffB);
            PG8_BAR; PG8_WAIT_L(0); PG8_MMA(0, 1, At, B1); PG8_BAR;
            PG8_LDA(At, 1, 1); PG8_STAGE(PG8_SA(1, 0), a3, voffA);
            PG8_BAR; PG8_WAIT_L(0); PG8_MMA(1, 0, At, B0); PG8_BAR; PG8_SCHED;
            PG8_STAGE(PG8_SB(1, 1), b3 + hstep, voffB);
            PG8_WAIT_V(6); PG8_BAR; PG8_MMA(1, 1, At, B1); PG8_BAR;
            }
        }
        if constexpr (ALIGN_EPI) { if (wr == 0) PG8_BAR; }
        if constexpr (!Epi::AFTER_DRAIN) { E(acc, cur, wr, wc, fr, fq); S.done(cur); }
        if (!has_next) break;
        if (cur.part != 0) {
#pragma unroll
        for (int a = 0; a < 2; ++a)
#pragma unroll
            for (int b = 0; b < 2; ++b)
#pragma unroll
                for (int m = 0; m < 4; ++m)
#pragma unroll
                    for (int n = 0; n < 2; ++n) acc[a][b][m][n] = (f32x4){0.f, 0.f, 0.f, 0.f};
        }
        cur = nxt; cA = nA; cB = nB; ++ui;
        if constexpr (ALIGN_EPI) { if (wr == 1) PG8_BAR; }
    }
    PG8_WAIT_V(0);
    if constexpr (!ALIGN_EPI) { if (wr == 0) PG8_BAR; }
    PG8_BAR;
    if constexpr (Epi::AFTER_DRAIN) { E.fused(acc, cur, wr, wc, fr, fq, lds, wid, lane); S.done(cur); }
#undef PG8_SA
#undef PG8_SB
#undef PG8_STAGE
#undef PG8_LDA
#undef PG8_LDB
#undef PG8_MMA
#undef PG8_WAIT_V
#undef PG8_WAIT_L
#undef PG8_BAR
#undef PG8_SCHED
}
}

using pg8::bf16_t; using pg8::bf16x8; using pg8::f32x4; using pg8::u32x4; using pg8::u32x2; using pg8::cvt_pk_bf16; using pg8::pk4; using pg8::unpk4; using pg8::bf1;
typedef float f32x16 __attribute__((ext_vector_type(16)));
#define LAS __attribute__((address_space(3)))
typedef LAS unsigned char lds_u8;

constexpr int NT_SB = 32768;
constexpr int DM = 1024, NIN = 4352, NUP = 5632, DFF = 2816;
constexpr size_t MiB = 1u << 20;
constexpr size_t WS_TAB = 0, WS_DEC = 16384 * 2, WS_BAR = 65536;
constexpr size_t WS_WIN = 1 * MiB, WS_WAO = 18 * MiB, WS_WRO = 20 * MiB, WS_WOUT = 22 * MiB, WS_WUP = 26 * MiB, WS_WDN = 48 * MiB;
constexpr size_t WS_SS = 60 * MiB, WS_XB = 64 * MiB;
constexpr size_t WS_QA = 128 * MiB, WS_KA = 160 * MiB, WS_VAT = 168 * MiB, WS_QR = 176 * MiB, WS_KR = 192 * MiB, WS_KTF = 208 * MiB, WS_KTB = 224 * MiB,
                 WS_VRT = 240 * MiB, WS_GR = 272 * MiB, WS_GATES = 304 * MiB, WS_AO = 432 * MiB, WS_RG = 464 * MiB, WS_KV = 496 * MiB;
constexpr size_t WS_U = 128 * MiB;
constexpr size_t WS_MG = 560 * MiB, WS_RT = 624 * MiB, WS_ACT = 656 * MiB, WS_END = 832 * MiB;
constexpr int LDS_BYTES = 161024;
constexpr int LDS_RT = 132096, LDS_XCH = 144384;

__device__ __forceinline__ f32x16 mfma32(bf16x8 a, bf16x8 b, f32x16 c) { return __builtin_amdgcn_mfma_f32_32x32x16_bf16(a, b, c, 0, 0, 0); }
__device__ __forceinline__ int crow(int r, int hi) { return (r & 3) + 8 * (r >> 2) + 4 * hi; }
__device__ __forceinline__ int pi32(int r) { return (r & ~12) | ((r & 4) << 1) | ((r & 8) >> 1); }
__device__ __forceinline__ bf16x8 pack8(const f32x16& p, int b) {
    u32x4 w; w.x = cvt_pk_bf16(p[b], p[b + 1]); w.y = cvt_pk_bf16(p[b + 2], p[b + 3]); w.z = cvt_pk_bf16(p[b + 4], p[b + 5]); w.w = cvt_pk_bf16(p[b + 6], p[b + 7]);
    return __builtin_bit_cast(bf16x8, w);
}
__device__ __forceinline__ bf16x8 scale8(bf16x8 q, float s) {
    const u32x4 w = __builtin_bit_cast(u32x4, q); u32x4 o;
#pragma unroll
    for (int i = 0; i < 4; ++i) o[i] = cvt_pk_bf16(__uint_as_float(w[i] << 16) * s, __uint_as_float(w[i] & 0xffff0000u) * s);
    return __builtin_bit_cast(bf16x8, o);
}
__device__ __forceinline__ float wave_sum(float v) {
#pragma unroll
    for (int o = 1; o < 64; o <<= 1) v += __shfl_xor(v, o);
    return v;
}
__device__ __forceinline__ float wave_max(float v) {
#pragma unroll
    for (int o = 1; o < 64; o <<= 1) v = fmaxf(v, __shfl_xor(v, o));
    return v;
}

__device__ __forceinline__ int tile_in(int tp) { return (tp == 2) ? 4 : (tp == 4) ? 2 : (tp == 5) ? 10 : (tp == 10) ? 5 : tp; }
__device__ __forceinline__ int map_in(int np) { const int tl = tile_in(np >> 8), pc = np & 255; if (tl >= 5) return (tl << 8) + pc; return (tl << 8) + 64 * ((pc >> 5) & 3) + 32 * (pc >> 7) + (pc & 31); }
__device__ __forceinline__ int map_up(int np) { const int j = np >> 8, pc = np & 255; return pc < 128 ? 128 * j + pc : DFF + 128 * j + (pc - 128); }
template <int MODE> __device__ __forceinline__ void conv_item(const float* __restrict__ W, int K, int N, bf16_t* __restrict__ Wt, int ldw, const float* __restrict__ g, int item, LAS float* scr, int lane) {
    const int nkb = K >> 6, kb = item % nkb, nb = item / nkb, k0 = kb << 6, n0 = nb << 5;
    const int nn = lane & 31, np = n0 + nn, ncol = (MODE == 1) ? map_in(np) : (MODE == 2) ? map_up(np) : np;
    float wv[32];
#pragma unroll
    for (int i = 0; i < 32; ++i) wv[i] = W[(size_t)(k0 + 2 * i + (lane >> 5)) * N + ncol];
    if (g) {
#pragma unroll
        for (int i = 0; i < 32; ++i) wv[i] *= g[k0 + 2 * i + (lane >> 5)];
    }
#pragma unroll
    for (int i = 0; i < 32; ++i) scr[(2 * i + (lane >> 5)) * 33 + nn] = wv[i];
    __builtin_amdgcn_s_waitcnt(0xc07f); __builtin_amdgcn_wave_barrier();
    const int cch = lane & 7;
#pragma unroll
    for (int j = 0; j < 4; ++j) {
        const int n = (lane >> 3) + 8 * j; const LAS float* sp = scr + (8 * cch) * 33 + n;
        u32x4 o; o.x = cvt_pk_bf16(sp[0 * 33], sp[1 * 33]); o.y = cvt_pk_bf16(sp[2 * 33], sp[3 * 33]); o.z = cvt_pk_bf16(sp[4 * 33], sp[5 * 33]); o.w = cvt_pk_bf16(sp[6 * 33], sp[7 * 33]);
        *(u32x4*)(Wt + (size_t)(n0 + n) * ldw + k0 + 8 * cch) = o;
    }
    __builtin_amdgcn_s_waitcnt(0xc07f); __builtin_amdgcn_wave_barrier();
}

__device__ __forceinline__ void attn_unit(const bf16_t* __restrict__ Qa, const bf16_t* __restrict__ Ka, const bf16_t* __restrict__ Vat, bf16_t* __restrict__ AO,
                                          int seq, int kvh, int qb, int S, float negM, lds_u8* lds) {
    const int tid = ltid(), lane = tid & 63, w = __builtin_amdgcn_readfirstlane(tid >> 6), r32 = lane & 31, hi = lane >> 5;
    const int head = kvh * 4 + (w >> 1);
    const size_t tq = (size_t)seq * S + qb * 128 + (w & 1) * 64;
    bf16x8 qr[2][4];
#pragma unroll
    for (int qi = 0; qi < 2; ++qi)
#pragma unroll
        for (int d0 = 0; d0 < 4; ++d0) qr[qi][d0] = *(const bf16x8*)(Qa + (tq + qi * 32 + r32) * 512 + head * 64 + d0 * 16 + hi * 8);
    f32x16 o[2][2];
#pragma unroll
    for (int qi = 0; qi < 2; ++qi)
#pragma unroll
        for (int db = 0; db < 2; ++db)
#pragma unroll
            for (int r = 0; r < 16; ++r) o[qi][db][r] = 0.f;
    float lsum[2] = {0.f, 0.f};
    const bf16_t* Kg = Ka + (size_t)seq * S * 128 + kvh * 64;
    const bf16_t* Vg = Vat + ((size_t)(seq * 2 + kvh) * 64) * S;
    const int sr = tid >> 3, sc = (tid & 7) * 8;
    constexpr int ROWB = 144, TILEB = 64 * ROWB;
    lds_u8* Kl = lds; lds_u8* Vl = lds + 2 * TILEB;
    const int NT = S >> 6;
    u32x4 kreg = *(const u32x4*)(Kg + (size_t)sr * 128 + sc);
    u32x4 vreg = *(const u32x4*)(Vg + (size_t)sr * S + sc);
    *(LAS u32x4*)(Kl + sr * ROWB + sc * 2) = kreg; *(LAS u32x4*)(Vl + sr * ROWB + sc * 2) = vreg;
    __syncthreads();
    const int pr = pi32(r32);
    if (w >= 4) __builtin_amdgcn_s_setprio(1);
    f32x16 negm;
#pragma unroll
    for (int r = 0; r < 16; ++r) negm[r] = negM;
    asm volatile("" : "+v"(negm));
#pragma unroll 1
    for (int t = 0; t < NT; ++t) {
        const int cur = t & 1;
        if (t + 1 < NT) { kreg = *(const u32x4*)(Kg + (size_t)((t + 1) * 64 + sr) * 128 + sc); vreg = *(const u32x4*)(Vg + (size_t)sr * S + (t + 1) * 64 + sc); }
        const lds_u8* Kc = Kl + cur * TILEB; const lds_u8* Vc = Vl + cur * TILEB;
        bf16x8 pa[2][4];
#pragma unroll
        for (int kb = 0; kb < 2; ++kb) {
            bf16x8 kf[4];
#pragma unroll
            for (int d0 = 0; d0 < 4; ++d0) kf[d0] = *(const LAS bf16x8*)(Kc + (kb * 32 + pr) * ROWB + d0 * 32 + hi * 16);
#pragma unroll
            for (int qi = 0; qi < 2; ++qi) {
                f32x16 p = mfma32(kf[0], qr[qi][0], negm);
#pragma unroll
                for (int d0 = 1; d0 < 4; ++d0) p = mfma32(kf[d0], qr[qi][d0], p);
#pragma unroll
                for (int r = 0; r < 16; ++r) p[r] = __builtin_amdgcn_exp2f(p[r]);
                pg8::f32x2 s2 = {p[0], p[1]};
#pragma unroll
                for (int r = 2; r < 16; r += 2) s2 += (pg8::f32x2){p[r], p[r + 1]};
                lsum[qi] += s2.x + s2.y;
                pa[qi][2 * kb] = pack8(p, 0); pa[qi][2 * kb + 1] = pack8(p, 8);
            }
        }
#pragma unroll
        for (int ks = 0; ks < 4; ++ks) {
            const bf16x8 v0 = *(const LAS bf16x8*)(Vc + r32 * ROWB + ks * 32 + hi * 16);
            const bf16x8 v1 = *(const LAS bf16x8*)(Vc + (32 + r32) * ROWB + ks * 32 + hi * 16);
#pragma unroll
            for (int qi = 0; qi < 2; ++qi) { o[qi][0] = mfma32(pa[qi][ks], v0, o[qi][0]); o[qi][1] = mfma32(pa[qi][ks], v1, o[qi][1]); }
        }
        if (t + 1 < NT) { *(LAS u32x4*)(Kl + (cur ^ 1) * TILEB + sr * ROWB + sc * 2) = kreg; *(LAS u32x4*)(Vl + (cur ^ 1) * TILEB + sr * ROWB + sc * 2) = vreg; }
        __syncthreads();
    }
    __builtin_amdgcn_s_setprio(0);
    LAS float* wsf = (LAS float*)(lds + 36864) + w * 64;
    lds_u8* stg = lds + w * 4608;
#pragma unroll
    for (int qi = 0; qi < 2; ++qi) { float l = lsum[qi]; l += __shfl_xor(l, 32); if (hi == 0) wsf[qi * 32 + r32] = l; }
    __builtin_amdgcn_s_waitcnt(0xc07f);
    __builtin_amdgcn_wave_barrier();
#pragma unroll
    for (int qi = 0; qi < 2; ++qi) {
#pragma unroll
        for (int r = 0; r < 16; ++r) {
            const int q = crow(r, hi); const float inv = 1.0f / wsf[qi * 32 + q];
            *(LAS bf16_t*)(stg + q * 144 + r32 * 2) = bf1(o[qi][0][r] * inv); *(LAS bf16_t*)(stg + q * 144 + (32 + r32) * 2) = bf1(o[qi][1][r] * inv);
        }
        __builtin_amdgcn_s_waitcnt(0xc07f);
        __builtin_amdgcn_wave_barrier();
#pragma unroll
        for (int i = 0; i < 4; ++i) {
            const int row = i * 8 + (lane >> 3), ch = lane & 7;
            const u32x4 yv = *(const LAS u32x4*)(stg + row * 144 + ch * 16);
            *(u32x4*)(AO + (tq + qi * 32 + row) * 1024 + head * 64 + ch * 8) = yv;
        }
        __builtin_amdgcn_s_waitcnt(0xc07f);
        __builtin_amdgcn_wave_barrier();
    }
    __syncthreads();
}

constexpr int R1_VT = 0, R1_KF = 34816, R1_KB = 52224, R1_BYTES = 69632;
struct R1Regs { u32x4 v[4], kf[2], kb[2]; };
__device__ __forceinline__ void r1_load(R1Regs& g, const bf16_t* __restrict__ Vrt, const bf16_t* __restrict__ Ktf, const bf16_t* __restrict__ Ktb, int u, int S, int sshift, int tid) {
    const int chunk = u >> 2, h = u & 3, t0 = chunk * 128, seq = t0 >> sshift, s0 = t0 & (S - 1);
#pragma unroll
    for (int i = 0; i < 4; ++i) { const int id = tid + i * 512, row = id >> 4, cc = (id & 15) * 8; g.v[i] = *(const u32x4*)(Vrt + ((size_t)(seq * 4 + h) * 128 + row) * S + s0 + cc); }
#pragma unroll
    for (int i = 0; i < 2; ++i) { const int id = tid + i * 512, row = id >> 4, cc = (id & 15) * 8; const size_t o = ((size_t)(seq * 4 + h) * 64 + row) * S + s0 + cc;
        g.kf[i] = *(const u32x4*)(Ktf + o); g.kb[i] = *(const u32x4*)(Ktb + o); }
}
__device__ __forceinline__ void r1_phase(const bf16_t* __restrict__ Vrt, const bf16_t* __restrict__ Ktf, const bf16_t* __restrict__ Ktb, float* __restrict__ KV, int S, int sshift, int G, int bx, lds_u8* lds) {
    const int tid = ltid(), lane = tid & 63, w = __builtin_amdgcn_readfirstlane(tid >> 6), r32 = lane & 31, hi = lane >> 5;
    const int dir = w & 1, dvb = w >> 1;
    const int NU = (NT_SB / 128) * 4;
    R1Regs g;
    int u = bx;
    if (u < NU) r1_load(g, Vrt, Ktf, Ktb, u, S, sshift, tid);
#pragma unroll 1
    for (; u < NU; u += G) {
        const int chunk = u >> 2, h = u & 3;
#pragma unroll
        for (int i = 0; i < 4; ++i) { const int id = tid + i * 512, row = id >> 4, cb = (id & 15) * 16; *(LAS u32x4*)(lds + R1_VT + row * 272 + cb) = g.v[i]; }
#pragma unroll
        for (int i = 0; i < 2; ++i) { const int id = tid + i * 512, row = id >> 4, cb = (id & 15) * 16; *(LAS u32x4*)(lds + R1_KF + row * 272 + cb) = g.kf[i]; *(LAS u32x4*)(lds + R1_KB + row * 272 + cb) = g.kb[i]; }
        __syncthreads();
        if (u + G < NU) r1_load(g, Vrt, Ktf, Ktb, u + G, S, sshift, tid);
        f32x16 acc[2];
#pragma unroll
        for (int b = 0; b < 2; ++b)
#pragma unroll
            for (int r = 0; r < 16; ++r) acc[b][r] = 0.f;
        const lds_u8* Kt = lds + (dir ? R1_KB : R1_KF);
#pragma unroll
        for (int ks = 0; ks < 8; ++ks) {
            const bf16x8 va = *(const LAS bf16x8*)(lds + R1_VT + (dvb * 32 + r32) * 272 + ks * 32 + hi * 16);
#pragma unroll
            for (int b = 0; b < 2; ++b) { const bf16x8 kb = *(const LAS bf16x8*)(Kt + (b * 32 + r32) * 272 + ks * 32 + hi * 16); acc[b] = mfma32(va, kb, acc[b]); }
        }
        float* out = KV + ((size_t)(chunk * 4 + h) * 2 + dir) * 8192;
#pragma unroll
        for (int b = 0; b < 2; ++b)
#pragma unroll
            for (int r = 0; r < 16; ++r) out[(dvb * 32 + crow(r, hi)) * 64 + b * 32 + r32] = acc[b][r];
        __syncthreads();
    }
}

constexpr int R3_KT = 0, R3_QT = 18432, R3_VT = 36864, R3_RF = 71680, R3_RB = 90112, R3_PART = 108544, R3_BYTES = 109568;
struct R3Regs { u32x4 k[2], q[2], v[4], rf[2], rb[2]; };
__device__ __forceinline__ void r3_load(R3Regs& g, const bf16_t* __restrict__ Qr, const bf16_t* __restrict__ Kr, const bf16_t* __restrict__ Vrt, const bf16_t* __restrict__ RT, int u, int S, int sshift, int tid) {
    const int chunk = u >> 2, h = u & 3, t0 = chunk * 128, seq = t0 >> sshift, s0 = t0 & (S - 1);
#pragma unroll
    for (int i = 0; i < 2; ++i) { const int id = tid + i * 512, row = id >> 3, cc = (id & 7) * 8;
        g.k[i] = *(const u32x4*)(Kr + (size_t)(t0 + row) * 256 + h * 64 + cc); g.q[i] = *(const u32x4*)(Qr + (size_t)(t0 + row) * 256 + h * 64 + cc);
        g.rf[i] = *(const u32x4*)(RT + ((size_t)(chunk * 4 + h) * 2) * 8192 + id * 8); g.rb[i] = *(const u32x4*)(RT + ((size_t)(chunk * 4 + h) * 2 + 1) * 8192 + id * 8); }
#pragma unroll
    for (int i = 0; i < 4; ++i) { const int id = tid + i * 512, row = id >> 4, cc = (id & 15) * 8;
        g.v[i] = *(const u32x4*)(Vrt + ((size_t)(seq * 4 + h) * 128 + row) * S + s0 + cc); }
}
__device__ __forceinline__ void r3_stage(const R3Regs& g, lds_u8* lds, int tid) {
#pragma unroll
    for (int i = 0; i < 2; ++i) { const int id = tid + i * 512, row = id >> 3, cb = (id & 7) * 16;
        *(LAS u32x4*)(lds + R3_KT + row * 144 + cb) = g.k[i]; *(LAS u32x4*)(lds + R3_QT + row * 144 + cb) = g.q[i];
        *(LAS u32x4*)(lds + R3_RF + row * 144 + cb) = g.rf[i]; *(LAS u32x4*)(lds + R3_RB + row * 144 + cb) = g.rb[i]; }
#pragma unroll
    for (int i = 0; i < 4; ++i) { const int id = tid + i * 512, row = id >> 4, cb = (id & 15) * 16; *(LAS u32x4*)(lds + R3_VT + row * 272 + cb) = g.v[i]; }
}
__device__ __forceinline__ void r3_phase(const bf16_t* __restrict__ Qr, const bf16_t* __restrict__ Kr, const bf16_t* __restrict__ Vrt, const bf16_t* __restrict__ RT,
                                         const bf16_t* __restrict__ Gr, bf16_t* __restrict__ RG, const float* __restrict__ dec2, int S, int sshift, int G, int bx, lds_u8* lds) {
    const int tid = ltid(), lane = tid & 63, w = __builtin_amdgcn_readfirstlane(tid >> 6), r32 = lane & 31, hi = lane >> 5;
    const int qblk = w >> 1, dvh = w & 1;
    const int NU = (NT_SB / 128) * 4;
    R3Regs g;
    int u = bx;
    if (u < NU) r3_load(g, Qr, Kr, Vrt, RT, u, S, sshift, tid);
    const int pr = pi32(r32);
#pragma unroll 1
    for (; u < NU; u += G) {
        const int chunk = u >> 2, h = u & 3, t0 = chunk * 128;
        const float lf2 = dec2[h], lb2 = dec2[4 + h];
        r3_stage(g, lds, tid);
        __syncthreads();
        if (u + G < NU) r3_load(g, Qr, Kr, Vrt, RT, u + G, S, sshift, tid);
        const int iq = qblk * 32 + r32;
        bf16x8 qraw[4];
#pragma unroll
        for (int d0 = 0; d0 < 4; ++d0) qraw[d0] = *(const LAS bf16x8*)(lds + R3_QT + iq * 144 + d0 * 32 + hi * 16);
        const float sf = __builtin_amdgcn_exp2f(lf2 * (float)(iq + 1)), sb = __builtin_amdgcn_exp2f(lb2 * (float)(128 - iq));
        f32x16 acc[2];
#pragma unroll
        for (int a = 0; a < 2; ++a)
#pragma unroll
            for (int r = 0; r < 16; ++r) acc[a][r] = 0.f;
#pragma unroll
        for (int d0 = 0; d0 < 4; ++d0) {
            const bf16x8 qf = scale8(qraw[d0], sf), qb = scale8(qraw[d0], sb);
#pragma unroll
            for (int a = 0; a < 2; ++a) {
                const int dv = dvh * 64 + a * 32 + r32;
                const bf16x8 rf = *(const LAS bf16x8*)(lds + R3_RF + dv * 144 + d0 * 32 + hi * 16);
                const bf16x8 rb = *(const LAS bf16x8*)(lds + R3_RB + dv * 144 + d0 * 32 + hi * 16);
                acc[a] = mfma32(qf, rf, acc[a]); acc[a] = mfma32(qb, rb, acc[a]);
            }
        }
#pragma unroll
        for (int kb = 0; kb < 4; ++kb) {
            f32x16 st;
#pragma unroll
            for (int r = 0; r < 16; ++r) st[r] = 0.f;
#pragma unroll
            for (int d0 = 0; d0 < 4; ++d0) {
                const bf16x8 kf = *(const LAS bf16x8*)(lds + R3_KT + (kb * 32 + pr) * 144 + d0 * 32 + hi * 16);
                st = mfma32(kf, qraw[d0], st);
            }
#pragma unroll
            for (int r = 0; r < 16; ++r) {
                const int j = kb * 32 + 16 * (r >> 3) + 8 * hi + (r & 7);
                const float dd = (float)(iq - j);
                const float e = (dd >= 0.f) ? lf2 * dd : -lb2 * dd;
                st[r] *= __builtin_amdgcn_exp2f(e);
            }
            bf16x8 pa[2]; pa[0] = pack8(st, 0); pa[1] = pack8(st, 8);
#pragma unroll
            for (int s = 0; s < 2; ++s)
#pragma unroll
                for (int a = 0; a < 2; ++a) {
                    const bf16x8 vf = *(const LAS bf16x8*)(lds + R3_VT + (dvh * 64 + a * 32 + r32) * 272 + kb * 64 + s * 32 + hi * 16);
                    acc[a] = mfma32(pa[s], vf, acc[a]);
                }
        }
        LAS float* part = (LAS float*)(lds + R3_PART);
        float ssq[16];
#pragma unroll
        for (int r = 0; r < 16; ++r) {
            float q = acc[0][r] * acc[0][r] + acc[1][r] * acc[1][r];
            q += __shfl_xor(q, 1); q += __shfl_xor(q, 2); q += __shfl_xor(q, 4); q += __shfl_xor(q, 8); q += __shfl_xor(q, 16);
            ssq[r] = q;
            if (r32 == 0) part[(qblk * 2 + dvh) * 32 + crow(r, hi)] = q;
        }
        __syncthreads();
        lds_u8* stg = lds + w * 4608;
#pragma unroll
        for (int r = 0; r < 16; ++r) {
            const int qrow = crow(r, hi);
            const float tot = ssq[r] + part[(qblk * 2 + (dvh ^ 1)) * 32 + qrow];
            const float inv = rsqrtf(tot * (1.0f / 128.0f) + EPS_F);
#pragma unroll
            for (int a = 0; a < 2; ++a) *(LAS bf16_t*)(stg + qrow * 144 + (a * 32 + r32) * 2) = bf1(acc[a][r] * inv);
        }
        __builtin_amdgcn_s_waitcnt(0xc07f);
        __builtin_amdgcn_wave_barrier();
#pragma unroll
        for (int i = 0; i < 4; ++i) {
            const int row = i * 8 + (lane >> 3), ch = lane & 7;
            const u32x4 yv = *(const LAS u32x4*)(stg + row * 144 + ch * 16);
            const size_t o = (size_t)(t0 + qblk * 32 + row) * 512 + h * 128 + dvh * 64 + ch * 8;
            const u32x4 gv = *(const u32x4*)(Gr + o);
            u32x4 ov;
#pragma unroll
            for (int e = 0; e < 4; ++e) ov[e] = cvt_pk_bf16(__uint_as_float(yv[e] << 16) * __uint_as_float(gv[e] << 16), __uint_as_float(yv[e] & 0xffff0000u) * __uint_as_float(gv[e] & 0xffff0000u));
            *(u32x4*)(RG + (size_t)(t0 + qblk * 32 + row) * 1024 + 512 + h * 128 + dvh * 64 + ch * 8) = ov;
        }
        __syncthreads();
    }
}

#define XB_TMO      128
#define XB_XCNT(j)  (256  + 64 * (j))
#define XB_XSUB(j)  (1280 + 64 * (j))
#define XB_XGEN(j)  (2304 + 64 * (j))
#define XB_TOP      3328
#define XB_TOPGEN   3392
#define XCD_BAR_WORDS 3456
#define XB_SPIN_CAP (1u << 18)

__device__ __forceinline__ unsigned xb_ld(unsigned* p)              { return __hip_atomic_load(p, __ATOMIC_RELAXED, __HIP_MEMORY_SCOPE_AGENT); }
__device__ __forceinline__ unsigned xb_add(unsigned* p, unsigned v) { return __hip_atomic_fetch_add(p, v, __ATOMIC_RELAXED, __HIP_MEMORY_SCOPE_AGENT); }
__device__ __forceinline__ unsigned xb_xcc_id() { return (unsigned)__builtin_amdgcn_s_getreg((3 << 11) | 20) & 0xFu; }
#define XB_SPIN(cond, bar) do { unsigned _sp = 0; while (cond) { __builtin_amdgcn_s_sleep(1); \
    if ((++_sp & 255u) == 0u) { if (xb_ld(&(bar)[XB_TMO])) break; if (_sp > XB_SPIN_CAP) { atomicAdd(&(bar)[XB_TMO], 1u); break; } } } } while (0)

struct XcdBarrier {
    unsigned* bar; unsigned x;
    volatile LAS unsigned* st;
};

__device__ __forceinline__ XcdBarrier xcd_barrier_post(unsigned* bar, volatile LAS unsigned* st) {
    XcdBarrier b; b.bar = bar; b.x = xb_xcc_id(); b.st = st;
    if (threadIdx.x == 0) (void)xb_add(&bar[XB_XCNT(b.x)], 1u);
    return b;
}
__device__ __forceinline__ void xcd_barrier_complete(unsigned* bar, unsigned x, unsigned& nloc, unsigned& nx) {
    const unsigned G = gridDim.x * gridDim.y * gridDim.z;
    unsigned sum, cnt, mine, sp = 0u;
    for (;;) {
        sum = 0u; cnt = 0u; mine = 0u;
#pragma unroll
        for (unsigned j = 0; j < 16; ++j) { const unsigned c = xb_ld(&bar[XB_XCNT(j)]); sum += c; cnt += (c > 0u) ? 1u : 0u; mine = (j == x) ? c : mine; }
        if (sum == G) break;
        __builtin_amdgcn_s_sleep(1);
        if ((++sp & 255u) == 0u) { if (xb_ld(&bar[XB_TMO])) break; if (sp > XB_SPIN_CAP) { atomicAdd(&bar[XB_TMO], 1u); break; } }
    }
    nloc = mine > 0u ? mine : 1u; nx = cnt > 0u ? cnt : 1u;
}

__device__ __forceinline__ void xcd_barrier(const XcdBarrier& b) {
    asm volatile("s_waitcnt vmcnt(0)" ::: "memory");
    __syncthreads();
    if (threadIdx.x == 0) {
        unsigned* bar = b.bar;
        __builtin_amdgcn_s_waitcnt(0);
        unsigned nloc = b.st[0], nx = b.st[1];
        if (nloc == 0u) { xcd_barrier_complete(bar, b.x, nloc, nx); b.st[0] = nloc; b.st[1] = nx; }
        const unsigned old = xb_add(&bar[XB_XSUB(b.x)], 1u);
        const unsigned gen = old / nloc;
        if (old + 1u == (gen + 1u) * nloc) {
            __builtin_amdgcn_fence(__ATOMIC_RELEASE, "agent");
            asm volatile("s_waitcnt vmcnt(0)" ::: "memory");
            const unsigned og = xb_add(&bar[XB_TOP], 1u);
            const unsigned tg = og / nx;
            if (og + 1u == (tg + 1u) * nx) xb_add(&bar[XB_TOPGEN], 1u);
            else XB_SPIN(xb_ld(&bar[XB_TOPGEN]) == tg, bar);
            __builtin_amdgcn_fence(__ATOMIC_ACQUIRE, "agent");
            xb_add(&bar[XB_XGEN(b.x)], 1u);
            asm volatile("s_waitcnt vmcnt(0)" ::: "memory");
        } else {
            XB_SPIN(xb_ld(&bar[XB_XGEN(b.x)]) == gen, bar);
            __builtin_amdgcn_fence(__ATOMIC_ACQUIRE, "agent");
            asm volatile("s_waitcnt vmcnt(0)" ::: "memory");
        }
    }
    __syncthreads();
}

struct Args { const float* in[17]; float* out; unsigned char* ws; };
typedef __attribute__((address_space(4))) const Args CArgs;
__device__ __forceinline__ CArgs* kargs() { CArgs* p = (CArgs*)__builtin_amdgcn_kernarg_segment_ptr(); asm volatile("" : "+s"(p)); return p; }
#define WSP(T, off) ((T*)(ws + (off)))

__global__ void __launch_bounds__(512, 2) fwd_megakernel(Args a_unused) {
    extern __shared__ __attribute__((aligned(16))) unsigned char lds_raw[];
    cg::grid_group grid = cg::this_grid();
    lds_u8* lds = (lds_u8*)lds_raw;
    const int G = gridDim.x, bx = blockIdx.x;
    XcdBarrier bar;
    {
        volatile LAS unsigned* st = (volatile LAS unsigned*)(lds + 131072);
        if (threadIdx.x < 2) st[threadIdx.x] = 0u;
        __syncthreads();
        CArgs* A = kargs(); bar = xcd_barrier_post((unsigned*)(A->ws + WS_BAR), st);
    }
    if (gridDim.x == 0x7fffffffu) grid.sync();

    {
        CArgs* A = kargs(); unsigned char* ws = A->ws; const int tid = ltid(), lane = tid & 63, wave = __builtin_amdgcn_readfirstlane(tid >> 6); (void)lane; (void)wave;
        if (bx == 0) {
            float* decs = WSP(float, WS_DEC);
            if (tid < 16) { const int l = tid >> 3, j = tid & 7; const float x = (j < 4) ? A->in[6][l * 4 + j] : A->in[7][l * 4 + j - 4];
                decs[tid] = -log1pf(expf(-x)) * 1.4426950408889634f; }
        }
        LAS float* scr = (LAS float*)lds + wave * (64 * 33);
        constexpr int I_IN = 16 * 136, I_AO = 8 * 32, I_OUT = 16 * 32, I_UP = 16 * 176, I_DN = 44 * 32, I_L = I_IN + 2 * I_AO + I_OUT + I_UP + I_DN;
#pragma unroll 1
        for (int it = bx * 8 + wave; it < 2 * I_L; it += G * 8) {
            const int l = it / I_L; int r = it % I_L;
            if (r < I_IN) { conv_item<1>(A->in[3] + (size_t)l * DM * NIN, DM, NIN, WSP(bf16_t, WS_WIN) + (size_t)l * NIN * DM, DM, A->in[2] + l * DM, r, scr, lane); continue; } r -= I_IN;
            if (r < I_AO) { conv_item<0>(A->in[8] + (size_t)l * 512 * DM, 512, DM, WSP(bf16_t, WS_WAO) + (size_t)l * DM * DM, DM, nullptr, r, scr, lane); continue; } r -= I_AO;
            if (r < I_AO) { conv_item<0>(A->in[9] + (size_t)l * 512 * DM, 512, DM, WSP(bf16_t, WS_WAO) + (size_t)l * DM * DM + 512, DM, nullptr, r, scr, lane); continue; } r -= I_AO;
            if (r < I_OUT) { conv_item<0>(A->in[11] + (size_t)l * DM * DM, DM, DM, WSP(bf16_t, WS_WOUT) + (size_t)l * DM * DM, DM, nullptr, r, scr, lane); continue; } r -= I_OUT;
            if (r < I_UP) { conv_item<2>(A->in[13] + (size_t)l * DM * NUP, DM, NUP, WSP(bf16_t, WS_WUP) + (size_t)l * NUP * DM, DM, A->in[12] + l * DM, r, scr, lane); continue; } r -= I_UP;
            conv_item<0>(A->in[16] + (size_t)l * DFF * DM, DFF, DM, WSP(bf16_t, WS_WDN) + (size_t)l * DM * DFF, DFF, nullptr, r, scr, lane);
        }
    }

#pragma unroll 1
    for (int sb = 0; sb < 3; ++sb) {
        {
            CArgs* A = kargs(); unsigned char* ws = A->ws; const int tid = ltid(), lane = tid & 63, wave = __builtin_amdgcn_readfirstlane(tid >> 6); (void)lane; (void)wave;
            const float* xin = (sb == 0) ? A->in[0] : A->in[1] + (size_t)(sb - 1) * NT_SB * DM;
            bf16_t* xb = WSP(bf16_t, WS_XB); float* ss = WSP(float, WS_SS);
            const int gw = bx * 8 + wave, NGW = G * 8;
#pragma unroll 1
            for (int row = gw; row < NT_SB; row += 4 * NGW) {
                f32x4 v[4][4]; float q[4];
#pragma unroll
                for (int rr = 0; rr < 4; ++rr) { const int r1 = (row + rr * NGW < NT_SB) ? row + rr * NGW : row; const f32x4* xr = (const f32x4*)(xin + (size_t)r1 * DM) + lane;
#pragma unroll
                    for (int j = 0; j < 4; ++j) v[rr][j] = xr[64 * j]; }
#pragma unroll
                for (int rr = 0; rr < 4; ++rr) { float qq = 0.f;
#pragma unroll
                    for (int j = 0; j < 4; ++j) qq += (v[rr][j][0] * v[rr][j][0] + v[rr][j][1] * v[rr][j][1]) + (v[rr][j][2] * v[rr][j][2] + v[rr][j][3] * v[rr][j][3]);
                    q[rr] = wave_sum(qq); }
#pragma unroll
                for (int rr = 0; rr < 4; ++rr) { const int r2 = row + rr * NGW; if (r2 >= NT_SB) continue;
                    u32x2* o8 = (u32x2*)(xb + (size_t)r2 * DM) + lane;
#pragma unroll
                    for (int j = 0; j < 4; ++j) o8[64 * j] = pk4(v[rr][j]);
                    if (lane < 16) ss[(size_t)r2 * 16 + lane] = (lane == 0) ? q[rr] : 0.f; }
            }
        }
        xcd_barrier(bar);
#pragma unroll 1
        for (int l = 0; l < 2; ++l) {
            {
                CArgs* A = kargs(); unsigned char* ws = A->ws; const int tid = ltid(), lane = tid & 63, wave = __builtin_amdgcn_readfirstlane(tid >> 6); (void)lane; (void)wave;
                const int S = (sb == 0) ? 8192 : 2048, sshift = (sb == 0) ? 13 : 11;
                pg8::Gemm g{WSP(bf16_t, WS_XB), WSP(bf16_t, WS_WIN) + (size_t)l * NIN * DM, NT_SB, NIN, DM, DM}; pg8::StaticOrder So; So.init(NT_SB, NIN, G, bx);
                pg8::rstd_table(WSP(float, WS_SS), So, (LAS float*)(lds + LDS_RT));
                pg8::EpiIn E{(pg8::lds_cf*)(lds + LDS_RT), A->in[4] + l * 64, A->in[5] + l * 64, A->in[10] + l * 2048, WSP(float, WS_DEC) + l * 8,
                             WSP(bf16_t, WS_QA), WSP(bf16_t, WS_KA), WSP(bf16_t, WS_VAT), WSP(bf16_t, WS_QR), WSP(bf16_t, WS_KR), WSP(bf16_t, WS_KTF), WSP(bf16_t, WS_KTB),
                             WSP(bf16_t, WS_VRT), WSP(bf16_t, WS_GR), WSP(bf16_t, WS_GATES), S, sshift};
                pg8::gemm_phase<pg8::EpiIn, pg8::StaticOrder, true, true>(lds, g, So, E);
            }
            xcd_barrier(bar);
            {
                CArgs* A = kargs(); unsigned char* ws = A->ws; const int tid = ltid(), lane = tid & 63, wave = __builtin_amdgcn_readfirstlane(tid >> 6); (void)lane; (void)wave;
                const int S = (sb == 0) ? 8192 : 2048, sshift = (sb == 0) ? 13 : 11;
                const float mq = wave_max(fabsf(A->in[4][l * 64 + lane])), mk = wave_max(fabsf(A->in[5][l * 64 + lane]));
                const float negM = -11.541560327111707f * mq * mk;
                const int nq = S >> 7, nunits = (NT_SB / S) * 2 * nq;
#pragma unroll 1
                for (int u = bx; u < nunits; u += G) {
                    const int qb = u % nq, kvh = (u / nq) & 1, seq = u / (2 * nq);
                    attn_unit(WSP(bf16_t, WS_QA), WSP(bf16_t, WS_KA), WSP(bf16_t, WS_VAT), WSP(bf16_t, WS_AO), seq, kvh, qb, S, negM, lds);
                }
                r1_phase(WSP(bf16_t, WS_VRT), WSP(bf16_t, WS_KTF), WSP(bf16_t, WS_KTB), WSP(float, WS_KV), S, sshift, G, bx, lds);
            }
            xcd_barrier(bar);
            {
                CArgs* A = kargs(); unsigned char* ws = A->ws; const int tid = ltid(), lane = tid & 63, wave = __builtin_amdgcn_readfirstlane(tid >> 6); (void)lane; (void)wave;
                const int S = (sb == 0) ? 8192 : 2048;
                const float* dec2 = WSP(float, WS_DEC) + l * 8; const float* KV = WSP(float, WS_KV); bf16_t* RT = WSP(bf16_t, WS_RT);
                const int nc = S >> 7, nscan = (NT_SB / S) * 8 * 8192;
#pragma unroll 1
                for (int idx = bx * 512 + tid; idx < nscan; idx += G * 512) {
                    const int e = idx & 8191, rest = idx >> 13, dir = rest & 1, h = (rest >> 1) & 3, seq = rest >> 3;
                    const float dC = exp2f(dec2[dir * 4 + h] * 128.0f);
                    const size_t base = ((size_t)(seq * nc) * 4 + h) * 2 + dir;
                    float R = 0.f;
#pragma unroll 1
                    for (int cb = 0; cb < nc; cb += 16) {
                        float kv[16];
#pragma unroll
                        for (int i = 0; i < 16; ++i) { const int c = dir ? (nc - 1 - cb - i) : (cb + i); kv[i] = KV[(base + (size_t)c * 8) * 8192 + e]; }
#pragma unroll
                        for (int i = 0; i < 16; ++i) { const int c = dir ? (nc - 1 - cb - i) : (cb + i); RT[(base + (size_t)c * 8) * 8192 + e] = bf1(R); R = dC * R + kv[i]; }
                    }
                }
            }
            xcd_barrier(bar);
            {
                CArgs* A = kargs(); unsigned char* ws = A->ws; const int tid = ltid(), lane = tid & 63, wave = __builtin_amdgcn_readfirstlane(tid >> 6); (void)lane; (void)wave;
                const int S = (sb == 0) ? 8192 : 2048, sshift = (sb == 0) ? 13 : 11;
                r3_phase(WSP(bf16_t, WS_QR), WSP(bf16_t, WS_KR), WSP(bf16_t, WS_VRT), WSP(bf16_t, WS_RT), WSP(bf16_t, WS_GR), WSP(bf16_t, WS_AO), WSP(float, WS_DEC) + l * 8, S, sshift, G, bx, lds);
            }
            xcd_barrier(bar);
            {
                CArgs* A = kargs(); unsigned char* ws = A->ws; const int tid = ltid(), lane = tid & 63, wave = __builtin_amdgcn_readfirstlane(tid >> 6); (void)lane; (void)wave;
                pg8::PairOrder So; So.init(NT_SB, DM, G, bx, 512);
                pg8::Gemm g{WSP(bf16_t, WS_AO), WSP(bf16_t, WS_WAO) + (size_t)l * DM * DM, NT_SB, DM, 512, DM}; pg8::EpiMergeF E{WSP(bf16_t, WS_GATES), WSP(bf16_t, WS_MG)};
                pg8::gemm_phase<pg8::EpiMergeF, pg8::PairOrder, true, true>(lds, g, So, E);
            }
            xcd_barrier(bar);
            {
                CArgs* A = kargs(); unsigned char* ws = A->ws; const int tid = ltid(), lane = tid & 63, wave = __builtin_amdgcn_readfirstlane(tid >> 6); (void)lane; (void)wave;
                pg8::Gemm g{WSP(bf16_t, WS_MG), WSP(bf16_t, WS_WOUT) + (size_t)l * DM * DM, NT_SB, DM, DM, DM}; pg8::StaticOrder So; So.init(NT_SB, DM, G, bx);
                pg8::EpiResid<false> E{WSP(bf16_t, WS_XB), nullptr, WSP(float, WS_SS)};
                pg8::gemm_phase<pg8::EpiResid<false>, pg8::StaticOrder, true, true>(lds, g, So, E);
            }
            xcd_barrier(bar);
            {
                CArgs* A = kargs(); unsigned char* ws = A->ws; const int tid = ltid(), lane = tid & 63, wave = __builtin_amdgcn_readfirstlane(tid >> 6); (void)lane; (void)wave;
                pg8::Gemm g{WSP(bf16_t, WS_XB), WSP(bf16_t, WS_WUP) + (size_t)l * NUP * DM, NT_SB, NUP, DM, DM}; pg8::StaticOrder So; So.init(NT_SB, NUP, G, bx);
                pg8::rstd_table(WSP(float, WS_SS), So, (LAS float*)(lds + LDS_RT));
                pg8::EpiUpConv E{(pg8::lds_cf*)(lds + LDS_RT), (pg8::lds_f*)(lds + LDS_XCH), A->in[14] + (size_t)l * 3 * NUP, A->in[15] + (size_t)l * NUP, WSP(bf16_t, WS_ACT), WSP(bf16_t, WS_U)};
                pg8::gemm_phase<pg8::EpiUpConv, pg8::StaticOrder, true, true>(lds, g, So, E);
            }
            xcd_barrier(bar);
            {
                CArgs* A = kargs(); unsigned char* ws = A->ws; const int tid = ltid(), lane = tid & 63, wave = __builtin_amdgcn_readfirstlane(tid >> 6); (void)lane; (void)wave;
                const int S = (sb == 0) ? 8192 : 2048;
                const bf16_t* UE = WSP(bf16_t, WS_U); bf16_t* ACT = WSP(bf16_t, WS_ACT);
                const float* cw = A->in[14] + (size_t)l * 3 * NUP; const float* cb = A->in[15] + (size_t)l * NUP;
                constexpr int NCG = DFF / 8, NITEM = (NT_SB / 256) * 2 * NCG;
#pragma unroll 1
                for (int it = bx * 512 + tid; it < NITEM; it += G * 512) {
                    const int cgp = it % NCG, pe = it / NCG, p = pe >> 1, eg = pe & 1, v0 = cgp * 8;
                    const int t = p * 256 + (eg ? 255 : 0);
                    const int ucol = 256 * (v0 >> 7) + (v0 & 127);
                    const u32x4 zero = {0u, 0u, 0u, 0u};
                    u32x4 rw[3][2];
                    const bf16_t* r0; const bf16_t* r1; const bf16_t* r2; bool hp, hn;
                    if (eg == 0) { hp = (t & (S - 1)) != 0; hn = true; r0 = UE + ((size_t)(p - 1) * 4 + 3) * NUP; r1 = UE + ((size_t)p * 4 + 0) * NUP; r2 = UE + ((size_t)p * 4 + 1) * NUP; }
                    else { hp = true; hn = ((t + 1) & (S - 1)) != 0; r0 = UE + ((size_t)p * 4 + 2) * NUP; r1 = UE + ((size_t)p * 4 + 3) * NUP; r2 = UE + ((size_t)(p + 1) * 4 + 0) * NUP; }
#pragma unroll
                    for (int pp = 0; pp < 2; ++pp) {
                        rw[0][pp] = hp ? *(const u32x4*)(r0 + ucol + pp * 128) : zero;
                        rw[1][pp] = *(const u32x4*)(r1 + ucol + pp * 128);
                        rw[2][pp] = hn ? *(const u32x4*)(r2 + ucol + pp * 128) : zero;
                    }
                    float r[2][8];
#pragma unroll
                    for (int pp = 0; pp < 2; ++pp) {
                        float wv[3][8], bv[8];
#pragma unroll
                        for (int k = 0; k < 3; ++k) { const f32x4 x0 = *(const f32x4*)(cw + k * NUP + pp * DFF + v0), x1 = *(const f32x4*)(cw + k * NUP + pp * DFF + v0 + 4);
#pragma unroll
                            for (int e = 0; e < 4; ++e) { wv[k][e] = x0[e]; wv[k][4 + e] = x1[e]; } }
                        const f32x4 y0 = *(const f32x4*)(cb + pp * DFF + v0), y1 = *(const f32x4*)(cb + pp * DFF + v0 + 4);
#pragma unroll
                        for (int e = 0; e < 4; ++e) { bv[e] = y0[e]; bv[4 + e] = y1[e]; }
#pragma unroll
                        for (int e2 = 0; e2 < 4; ++e2) {
                            const float a0 = __uint_as_float(rw[0][pp][e2] << 16), a1 = __uint_as_float(rw[0][pp][e2] & 0xffff0000u);
                            const float b0 = __uint_as_float(rw[1][pp][e2] << 16), b1 = __uint_as_float(rw[1][pp][e2] & 0xffff0000u);
                            const float c0 = __uint_as_float(rw[2][pp][e2] << 16), c1 = __uint_as_float(rw[2][pp][e2] & 0xffff0000u);
                            r[pp][2 * e2] = a0 * wv[0][2 * e2] + b0 * wv[1][2 * e2] + c0 * wv[2][2 * e2] + bv[2 * e2];
                            r[pp][2 * e2 + 1] = a1 * wv[0][2 * e2 + 1] + b1 * wv[1][2 * e2 + 1] + c1 * wv[2][2 * e2 + 1] + bv[2 * e2 + 1];
                        }
                    }
                    u32x4 o;
#pragma unroll
                    for (int e2 = 0; e2 < 4; ++e2) {
                        const pg8::f32x2 gl = pg8::gelu_pk((pg8::f32x2){r[1][2 * e2], r[1][2 * e2 + 1]});
                        o[e2] = cvt_pk_bf16(gl.x * r[0][2 * e2], gl.y * r[0][2 * e2 + 1]);
                    }
                    *(u32x4*)(ACT + (size_t)t * DFF + v0) = o;
                }
            }
            xcd_barrier(bar);
            {
                CArgs* A = kargs(); unsigned char* ws = A->ws; const int tid = ltid(), lane = tid & 63, wave = __builtin_amdgcn_readfirstlane(tid >> 6); (void)lane; (void)wave;
                float* xout = A->out + (size_t)sb * NT_SB * DM;
                pg8::Gemm g{WSP(bf16_t, WS_ACT), WSP(bf16_t, WS_WDN) + (size_t)l * DM * DFF, NT_SB, DM, DFF, DFF}; pg8::StaticOrder So; So.init(NT_SB, DM, G, bx);
                if (l == 0) { pg8::EpiResid<false> E{WSP(bf16_t, WS_XB), nullptr, WSP(float, WS_SS)}; pg8::gemm_phase<pg8::EpiResid<false>, pg8::StaticOrder, true, true>(lds, g, So, E); }
                else { pg8::EpiResid<true> E{WSP(bf16_t, WS_XB), xout, nullptr}; pg8::gemm_phase<pg8::EpiResid<true>, pg8::StaticOrder, true, true>(lds, g, So, E); }
            }
            xcd_barrier(bar);
        }
    }
}

extern "C" void kernel_launch(void* const* d_in, const int* in_sizes, int n_in, void* d_out, int out_size, void* d_ws, size_t ws_size, hipStream_t stream) {
    static int grid = 0;
    if (grid == 0) {
        if (n_in != 17 || ws_size < WS_END) { fprintf(stderr, "kernel_launch: unexpected n_in %d / ws_size %zu\n", n_in, ws_size); grid = -1; return; }
        int dev = 0, cus = 0, per_cu = 0;
        hipGetDevice(&dev); hipDeviceGetAttribute(&cus, hipDeviceAttributeMultiprocessorCount, dev);
        if (hipFuncSetAttribute((const void*)fwd_megakernel, hipFuncAttributeMaxDynamicSharedMemorySize, LDS_BYTES) != hipSuccess) { fprintf(stderr, "kernel_launch: hipFuncSetAttribute failed\n"); grid = -1; return; }
        if (hipOccupancyMaxActiveBlocksPerMultiprocessor(&per_cu, (const void*)fwd_megakernel, 512, LDS_BYTES) != hipSuccess || per_cu < 1) { fprintf(stderr, "kernel_launch: occupancy query says %d\n", per_cu); per_cu = 1; }
        (void)hipGetLastError();
        grid = cus;
    }
    if (grid < 0) return;
    if (hipMemsetAsync((char*)d_ws + WS_BAR, 0, 16384, stream) != hipSuccess) { fprintf(stderr, "kernel_launch: memset of the barrier words failed\n"); return; }
    Args a{};
    for (int i = 0; i < 17; ++i) a.in[i] = (const float*)d_in[i];
    a.out = (float*)d_out; a.ws = (unsigned char*)d_ws;
    void* args[] = {&a};
    hipError_t e = hipLaunchCooperativeKernel((const void*)fwd_megakernel, dim3(grid), dim3(512), args, LDS_BYTES, stream);
    if (e != hipSuccess) fprintf(stderr, "cooperative launch failed: %s (grid %d)\n", hipGetErrorString(e), grid);
}
```

```cpp
#include <hip/hip_runtime.h>
#include <hip/hip_cooperative_groups.h>
#include <cstdio>
#include <cstdint>
namespace cg = cooperative_groups;

#define EPS_F 1e-6f
__device__ __forceinline__ int ltid() { int t = threadIdx.x; asm volatile("" : "+v"(t)); return t; }
namespace pg8 {
#define PG8_LAS __attribute__((address_space(3)))
typedef unsigned short bf16_t;
typedef short bf16x8 __attribute__((ext_vector_type(8)));
typedef float f32x4 __attribute__((ext_vector_type(4)));
typedef unsigned u32x4 __attribute__((ext_vector_type(4)));
constexpr int BM = 256, BK = 64, HALF = 128, HTB = HALF * BK * 2  , STAGE_BYTES = 8 * HTB, NXCD = 8, WGM = 8;

__host__ __device__ __forceinline__ int lds_byte(int r, int c) { const int st = (r >> 4) * 2 + (c >> 5), rr = r & 15, cc = c & 31, ob = rr * 64 + cc * 2; return st * 1024 + (ob ^ (((ob >> 9) & 1) << 5)); }
__host__ __device__ __forceinline__ void stage_rc(int b, int& R, int& C) { const int st = b / 1024, sb = b % 1024, swz = sb ^ (((sb >> 9) & 1) << 5); R = (st >> 1) * 16 + swz / 64; C = (st & 1) * 32 + (swz % 64) / 2; }
__host__ __device__ __forceinline__ int perm32(int rho) { const int n = rho >> 4, i = rho & 15; return 8 * (i >> 2) + 4 * n + (i & 3); }

struct Unit { int pm, pn, koff, part, ord; };
struct Gemm { const bf16_t* A; const bf16_t* Bt; int M, N, K, ld; };

struct StaticOrder {
    int nM, nN, nwg, G, c;
    __host__ __device__ void init(int M, int N, int G_, int c_) { nM = M / BM; nN = N / BM; nwg = nM * nN; G = G_; c = c_; }
    __host__ __device__ bool next(int i, Unit& u) const {
        const long L = (long)i * G + c; if (L >= nwg) return false;
        int wgid = (int)L; { const int q = nwg / NXCD, r = nwg % NXCD, xcd = wgid % NXCD, off = wgid / NXCD; wgid = (xcd < r ? xcd * (q + 1) : r * (q + 1) + (xcd - r) * q) + off; }
        const int nig = WGM * nN, gid = wgid / nig, fm = gid * WGM, gsz = (nM - fm) < WGM ? (nM - fm) : WGM;
        u.pm = fm + ((wgid % nig) % gsz); u.pn = (wgid % nig) / gsz; u.koff = 0; u.part = 1; u.ord = i; return true;
    }
    __device__ __forceinline__ void a_ready(const Unit&) const {}
    __device__ __forceinline__ void done(const Unit&) const {}
};

struct PairOrder {
    StaticOrder so; int kpart;
    __host__ __device__ void init(int M, int N, int G_, int c_, int kpart_) { so.init(M, N, G_, c_); kpart = kpart_; }
    __host__ __device__ bool next(int i, Unit& u) const { if (!so.next(i >> 1, u)) return false; u.ord = i >> 1; u.part = i & 1; u.koff = (i & 1) * kpart; return true; }
    __device__ __forceinline__ void a_ready(const Unit&) const {}
    __device__ __forceinline__ void done(const Unit&) const {}
};
typedef unsigned u32x2 __attribute__((ext_vector_type(2)));
typedef float f32x2_t __attribute__((ext_vector_type(2))); typedef __bf16 bf16x2_t __attribute__((ext_vector_type(2)));
__device__ __forceinline__ unsigned cvt_pk_bf16(float lo, float hi) { f32x2_t v = {lo, hi}; bf16x2_t b = __builtin_convertvector(v, bf16x2_t); return __builtin_bit_cast(unsigned, b); }
__device__ __forceinline__ u32x2 pk4(f32x4 v) { u32x2 w; w.x = cvt_pk_bf16(v[0], v[1]); w.y = cvt_pk_bf16(v[2], v[3]); return w; }
__device__ __forceinline__ bf16_t bf1(float v) { return (bf16_t)(cvt_pk_bf16(v, v) & 0xffffu); }
__device__ __forceinline__ f32x4 unpk4(u32x2 w) { f32x4 v; v[0] = __uint_as_float(w.x << 16); v[1] = __uint_as_float(w.x & 0xffff0000u); v[2] = __uint_as_float(w.y << 16); v[3] = __uint_as_float(w.y & 0xffff0000u); return v; }
__device__ __forceinline__ float row_rstd(const float* ss, int t) {
    const f32x4* sp = (const f32x4*)(ss + (size_t)t * 16);
    const f32x4 a0 = sp[0], a1 = sp[1], a2 = sp[2], a3 = sp[3];
    const float tot = (((a0[0] + a0[1]) + (a0[2] + a0[3])) + ((a1[0] + a1[1]) + (a1[2] + a1[3]))) + (((a2[0] + a2[1]) + (a2[2] + a2[3])) + ((a3[0] + a3[1]) + (a3[2] + a3[3])));
    return rsqrtf(tot * (1.0f / 1024.0f) + EPS_F);
}

typedef float f32x2 __attribute__((ext_vector_type(2)));
__device__ __forceinline__ f32x2 gelu_pk(f32x2 v) {
    const f32x2 av = __builtin_elementwise_abs(v), d = av * 0.2316418882f + 1.0f;
    f32x2 t; t.x = __builtin_amdgcn_rcpf(d.x); t.y = __builtin_amdgcn_rcpf(d.y);
    f32x2 q = t * 0.5307027145f + (-0.7265760135f); q = q * t + 0.7107068705f; q = q * t + (-0.142248368f); q = q * t + 0.127414796f; q = q * t;
    const f32x2 s = (v * v) * (-0.72134752044f);
    f32x2 e; e.x = __builtin_amdgcn_exp2f(s.x); e.y = __builtin_amdgcn_exp2f(s.y);
    const f32x2 m = v * (q * e), r = v - m;
    f32x2 o; o.x = v.x < 0.f ? m.x : r.x; o.y = v.y < 0.f ? m.y : r.y; return o;
}

typedef __attribute__((address_space(3))) const float lds_cf;
__device__ __forceinline__ void rows_rstd(lds_cf* rt, int ord, int wr, int fr, float (&rs)[2][4]) {
#pragma unroll
    for (int ai = 0; ai < 2; ++ai)
#pragma unroll
        for (int m = 0; m < 4; ++m) rs[ai][m] = rt[ord * BM + ai * HALF + wr * 64 + m * 16 + fr];
}
template <class Sched> __device__ __forceinline__ void rstd_table(const float* ss, const Sched& S, __attribute__((address_space(3))) float* rt) {
    const int tid = ltid(), half = tid >> 8, row = tid & 255;
    Unit u;
    for (int i = half; S.next(i, u); i += 2) {
        const f32x4* sp = (const f32x4*)(ss + (size_t)(u.pm * BM + row) * 16);
        const f32x4 s4 = (sp[0] + sp[1]) + (sp[2] + sp[3]);
        rt[i * BM + row] = rsqrtf(((s4[0] + s4[1]) + (s4[2] + s4[3])) * (1.0f / 1024.0f) + EPS_F);
    }
    __syncthreads();
}

struct EpiIn {
    static constexpr bool PERM = false, AFTER_DRAIN = false;
    lds_cf* rt; const float* gq; const float* gk; const float* bgate; const float* dec2;
    bf16_t *Qa, *Ka, *Vat, *Qr, *Kr, *Ktf, *Ktb, *Vrt, *Gr, *Gates;
    int S, sshift;
    __device__ __forceinline__ void operator()(const f32x4 (&acc)[2][2][4][2], const Unit& u, int wr, int wc, int fr, int fq) const {
        asm volatile("" : "+v"(fr), "+v"(fq));
        const int pn = (u.pn == 2) ? 4 : (u.pn == 4) ? 2 : (u.pn == 5) ? 10 : (u.pn == 10) ? 5 : u.pn;
        const int t00 = u.pm * BM + wr * 64 + fr;
        float rs[2][4];
        rows_rstd(rt, u.ord, wr, fr, rs);
        float lf2 = 0.f, lb2 = 0.f;
        f32x4 g4[2][2], b4[2][2];
        const bool do_norm = (pn <= 1) || (pn == 2 && wc < 2);
        if (pn == 4) { lf2 = dec2[wc]; lb2 = dec2[4 + wc]; }
        if (do_norm) { const float* gg = (pn <= 1) ? gq : gk;
#pragma unroll
            for (int bj = 0; bj < 2; ++bj)
#pragma unroll
                for (int n = 0; n < 2; ++n) g4[bj][n] = *(const f32x4*)(gg + 32 * bj + 16 * n + 4 * fq); }
        if (pn >= 9) {
#pragma unroll
            for (int bj = 0; bj < 2; ++bj)
#pragma unroll
                for (int n = 0; n < 2; ++n) b4[bj][n] = *(const f32x4*)(bgate + 256 * (pn - 9) + 32 * wc + 4 * fq + 128 * bj + 16 * n); }
        f32x4 frev;
#pragma unroll
        for (int e = 0; e < 4; ++e) frev[e] = __builtin_amdgcn_exp2f(-(float)(4 * fq + e) * 0.8304820237218406f) * 0.15915494309189535f;
#pragma unroll
        for (int ai = 0; ai < 2; ++ai)
#pragma unroll
            for (int m = 0; m < 4; ++m) {
                const int t = t00 + ai * HALF + m * 16;
                const float rstd = rs[ai][m];
                f32x4 v[2][2];
#pragma unroll
                for (int bj = 0; bj < 2; ++bj)
#pragma unroll
                    for (int n = 0; n < 2; ++n) v[bj][n] = acc[ai][bj][m][n] * rstd;
                const int s = t & (S - 1), seq = t >> sshift;
                if (pn <= 4) {
                    const bool isv = (pn == 2) && (wc >= 2);
                    if (do_norm) {
                        float q = 0.f;
#pragma unroll
                        for (int bj = 0; bj < 2; ++bj)
#pragma unroll
                            for (int n = 0; n < 2; ++n) { const f32x4 x = v[bj][n]; q += (x[0] * x[0] + x[1] * x[1]) + (x[2] * x[2] + x[3] * x[3]); }
                        q += __shfl_xor(q, 16); q += __shfl_xor(q, 32);
                        const float inv = rsqrtf(q * (1.0f / 64.0f) + EPS_F);
#pragma unroll
                        for (int bj = 0; bj < 2; ++bj)
#pragma unroll
                            for (int n = 0; n < 2; ++n) v[bj][n] = v[bj][n] * inv * g4[bj][n];
                    }
                    if (!isv) {
#pragma unroll
                        for (int bj = 0; bj < 2; ++bj) {
                            const float pos = (float)((bj == 0) ? (s >> 6) : (s & 63));
                            f32x4 c, sn;
#pragma unroll
                            for (int e = 0; e < 4; ++e) { float rev = pos * frev[e]; rev = rev - floorf(rev); c[e] = __builtin_amdgcn_cosf(rev); sn[e] = __builtin_amdgcn_sinf(rev); }
                            const f32x4 x1 = v[bj][0], x2 = v[bj][1];
                            v[bj][0] = x1 * c - x2 * sn; v[bj][1] = x2 * c + x1 * sn;
                        }
                    }
                    if (pn <= 1) {
                        bf16_t* dst = Qa + (size_t)t * 512 + (4 * pn + wc) * 64 + 4 * fq;
#pragma unroll
                        for (int bj = 0; bj < 2; ++bj)
#pragma unroll
                            for (int n = 0; n < 2; ++n) *(u32x2*)(dst + 32 * bj + 16 * n) = pk4(v[bj][n] * 0.18033688011112042f);
                    } else if (pn == 2) {
                        if (wc < 2) {
                            bf16_t* dst = Ka + (size_t)t * 128 + wc * 64 + 4 * fq;
#pragma unroll
                            for (int bj = 0; bj < 2; ++bj)
#pragma unroll
                                for (int n = 0; n < 2; ++n) *(u32x2*)(dst + 32 * bj + 16 * n) = pk4(v[bj][n]);
                        } else {
                            bf16_t* dst = Vat + ((size_t)(seq * 2 + (wc - 2)) * 64 + 4 * fq) * S + s;
#pragma unroll
                            for (int bj = 0; bj < 2; ++bj)
#pragma unroll
                                for (int n = 0; n < 2; ++n)
#pragma unroll
                                    for (int e = 0; e < 4; ++e) dst[(size_t)(32 * bj + 16 * n + e) * S] = bf1(v[bj][n][e]);
                        }
                    } else if (pn == 3) {
                        bf16_t* dst = Qr + (size_t)t * 256 + wc * 64 + 4 * fq;
#pragma unroll
                        for (int bj = 0; bj < 2; ++bj)
#pragma unroll
                            for (int n = 0; n < 2; ++n) *(u32x2*)(dst + 32 * bj + 16 * n) = pk4(v[bj][n]);
                    } else {
                        const int pc = s & 127;
                        const float df = __builtin_amdgcn_exp2f(lf2 * (float)(127 - pc)) * 0.125f, db = __builtin_amdgcn_exp2f(lb2 * (float)pc) * 0.125f;
                        bf16_t* dst = Kr + (size_t)t * 256 + wc * 64 + 4 * fq;
                        const size_t toff = ((size_t)(seq * 4 + wc) * 64 + 4 * fq) * S + s;
#pragma unroll
                        for (int bj = 0; bj < 2; ++bj)
#pragma unroll
                            for (int n = 0; n < 2; ++n) {
                                *(u32x2*)(dst + 32 * bj + 16 * n) = pk4(v[bj][n] * 0.125f);
#pragma unroll
                                for (int e = 0; e < 4; ++e) { const size_t o = toff + (size_t)(32 * bj + 16 * n + e) * S; Ktf[o] = bf1(v[bj][n][e] * df); Ktb[o] = bf1(v[bj][n][e] * db); }
                            }
                    }
                } else if (pn <= 6) {
#pragma unroll
                    for (int bj = 0; bj < 2; ++bj) {
                        bf16_t* dst = Vrt + ((size_t)(seq * 4 + 2 * (pn - 5) + bj) * 128 + 32 * wc + 4 * fq) * S + s;
#pragma unroll
                        for (int n = 0; n < 2; ++n)
#pragma unroll
                            for (int e = 0; e < 4; ++e) dst[(size_t)(16 * n + e) * S] = bf1(v[bj][n][e]);
                    }
                } else if (pn <= 8) {
                    bf16_t* dst = Gr + (size_t)t * 512 + 256 * (pn - 7) + 32 * wc + 4 * fq;
#pragma unroll
                    for (int bj = 0; bj < 2; ++bj)
#pragma unroll
                        for (int n = 0; n < 2; ++n) { f32x4 x = v[bj][n];
#pragma unroll
                            for (int e = 0; e < 4; ++e) x[e] = x[e] * __builtin_amdgcn_rcpf(1.0f + __builtin_amdgcn_exp2f(-1.4426950408889634f * x[e]));
                            *(u32x2*)(dst + 128 * bj + 16 * n) = pk4(x); }
                } else {
                    bf16_t* dst = Gates + (size_t)t * 2048 + 256 * (pn - 9) + 32 * wc + 4 * fq;
#pragma unroll
                    for (int bj = 0; bj < 2; ++bj)
#pragma unroll
                        for (int n = 0; n < 2; ++n) { f32x4 x = v[bj][n] + b4[bj][n];
#pragma unroll
                            for (int e = 0; e < 4; ++e) x[e] = __builtin_amdgcn_rcpf(1.0f + __builtin_amdgcn_exp2f(-1.4426950408889634f * x[e]));
                            *(u32x2*)(dst + 128 * bj + 16 * n) = pk4(x); }
                }
            }
    }
};

struct EpiMergeF {
    static constexpr bool PERM = false, AFTER_DRAIN = false;
    const bf16_t* Gates; bf16_t* Mg;
    __device__ __forceinline__ void operator()(f32x4 (&acc)[2][2][4][2], const Unit& u, int wr, int wc, int fr, int fq) const {
        asm volatile("" : "+v"(fr), "+v"(fq));
        const int t00 = u.pm * BM + wr * 64 + fr, c0 = u.pn * BM + 32 * wc + 4 * fq;
        if (u.part == 0) {
#pragma unroll
            for (int ai = 0; ai < 2; ++ai) {
                u32x2 ga[4][2][2], gr[4][2][2];
#pragma unroll
                for (int m = 0; m < 4; ++m)
#pragma unroll
                    for (int bj = 0; bj < 2; ++bj)
#pragma unroll
                        for (int n = 0; n < 2; ++n) { const bf16_t* gp = Gates + (size_t)(t00 + ai * HALF + m * 16) * 2048 + c0 + 128 * bj + 16 * n; ga[m][bj][n] = *(const u32x2*)gp; gr[m][bj][n] = *(const u32x2*)(gp + 1024); }
#pragma unroll
                for (int m = 0; m < 4; ++m)
#pragma unroll
                    for (int bj = 0; bj < 2; ++bj)
#pragma unroll
                        for (int n = 0; n < 2; ++n) { const f32x4 a4 = unpk4(ga[m][bj][n]), r4 = unpk4(gr[m][bj][n]); f32x4 r = acc[ai][bj][m][n];
#pragma unroll
                            for (int e = 0; e < 4; ++e) r[e] *= a4[e] * __builtin_amdgcn_rcpf(r4[e]);
                            acc[ai][bj][m][n] = r; }
            }
        } else {
            u32x2 gr[2][4][2][2];
#pragma unroll
            for (int ai = 0; ai < 2; ++ai)
#pragma unroll
                for (int m = 0; m < 4; ++m)
#pragma unroll
                    for (int bj = 0; bj < 2; ++bj)
#pragma unroll
                        for (int n = 0; n < 2; ++n) gr[ai][m][bj][n] = *(const u32x2*)(Gates + (size_t)(t00 + ai * HALF + m * 16) * 2048 + 1024 + c0 + 128 * bj + 16 * n);
#pragma unroll
            for (int ai = 0; ai < 2; ++ai)
#pragma unroll
                for (int m = 0; m < 4; ++m)
#pragma unroll
                    for (int bj = 0; bj < 2; ++bj)
#pragma unroll
                        for (int n = 0; n < 2; ++n) *(u32x2*)(Mg + (size_t)(t00 + ai * HALF + m * 16) * 1024 + c0 + 128 * bj + 16 * n) = pk4(acc[ai][bj][m][n] * unpk4(gr[ai][m][bj][n]));
        }
    }
};

template <bool FINAL> struct EpiResid {
    static constexpr bool PERM = false, AFTER_DRAIN = false;
    bf16_t* xb; float* out; float* ss;
    __device__ __forceinline__ void operator()(f32x4 (&acc)[2][2][4][2], const Unit& u, int wr, int wc, int fr, int fq) const {
        asm volatile("" : "+v"(fr), "+v"(fq));
        const int t00 = u.pm * BM + wr * 64 + fr, c0 = u.pn * BM + 32 * wc + 4 * fq;
        u32x2 xo[4][2][2];
#define RES_LOAD(ai) _Pragma("unroll") for (int m = 0; m < 4; ++m) _Pragma("unroll") for (int bj = 0; bj < 2; ++bj) _Pragma("unroll") for (int n = 0; n < 2; ++n) \
            xo[m][bj][n] = *(const u32x2*)(xb + (size_t)(t00 + (ai) * HALF + m * 16) * 1024 + c0 + 128 * bj + 16 * n);
#define RES_ADD(ai) _Pragma("unroll") for (int m = 0; m < 4; ++m) _Pragma("unroll") for (int bj = 0; bj < 2; ++bj) _Pragma("unroll") for (int n = 0; n < 2; ++n) acc[ai][bj][m][n] += unpk4(xo[m][bj][n]);
#define RES_STORE(ai) _Pragma("unroll") for (int m = 0; m < 4; ++m) { const int t = t00 + (ai) * HALF + m * 16; float q = 0.f; \
            _Pragma("unroll") for (int bj = 0; bj < 2; ++bj) _Pragma("unroll") for (int n = 0; n < 2; ++n) { const size_t o = (size_t)t * 1024 + c0 + 128 * bj + 16 * n; const f32x4 x = acc[ai][bj][m][n]; \
                if (FINAL) *(f32x4*)(out + o) = x; else { *(u32x2*)(xb + o) = pk4(x); q += (x[0] * x[0] + x[1] * x[1]) + (x[2] * x[2] + x[3] * x[3]); } } \
            if (!FINAL) { q += __shfl_xor(q, 16); q += __shfl_xor(q, 32); if (fq == 0) ss[(size_t)t * 16 + u.pn * 4 + wc] = q; } }
        RES_LOAD(0) RES_ADD(0) RES_LOAD(1) RES_STORE(0) RES_ADD(1) RES_STORE(1)
#undef RES_LOAD
#undef RES_ADD
#undef RES_STORE
    }
};

template <int CTRL> __device__ __forceinline__ float dpp_f(float v) { int iv = __builtin_bit_cast(int, v); asm volatile("" : "+v"(iv)); int r = __builtin_amdgcn_update_dpp(0, iv, CTRL, 0xF, 0xF, false); asm volatile("" : "+v"(r)); return __builtin_bit_cast(float, r); }
__device__ __forceinline__ f32x4 dpp_ror1(f32x4 v) { f32x4 r; r[0] = dpp_f<0x121>(v[0]); r[1] = dpp_f<0x121>(v[1]); r[2] = dpp_f<0x121>(v[2]); r[3] = dpp_f<0x121>(v[3]); return r; }
__device__ __forceinline__ f32x4 dpp_ror15(f32x4 v) { f32x4 r; r[0] = dpp_f<0x12F>(v[0]); r[1] = dpp_f<0x12F>(v[1]); r[2] = dpp_f<0x12F>(v[2]); r[3] = dpp_f<0x12F>(v[3]); return r; }
typedef __attribute__((address_space(3))) float lds_f;
struct EpiUpConv {
    static constexpr bool PERM = false, AFTER_DRAIN = false;
    lds_cf* rt; lds_f* xch; const float* cw; const float* cb; bf16_t* ACT; bf16_t* Uedge;
    __device__ __forceinline__ void operator()(f32x4 (&acc)[2][2][4][2], const Unit& u, int wr, int wc, int fr, int fq) const {
        asm volatile("" : "+v"(fr), "+v"(fq));
        float rs[2][4];
        rows_rstd(rt, u.ord, wr, fr, rs);
#pragma unroll
        for (int ai = 0; ai < 2; ++ai)
#pragma unroll
            for (int bj = 0; bj < 2; ++bj)
#pragma unroll
                for (int m = 0; m < 4; ++m)
#pragma unroll
                    for (int n = 0; n < 2; ++n) acc[ai][bj][m][n] *= rs[ai][m];
        lds_f* xb_ = xch + (u.ord & 1) * 2048 + wc * 512;
        if (fr == 0) {
#pragma unroll
            for (int ai = 0; ai < 2; ++ai)
#pragma unroll
                for (int bj = 0; bj < 2; ++bj)
#pragma unroll
                    for (int n = 0; n < 2; ++n) *(__attribute__((address_space(3))) f32x4*)(xb_ + ((2 * ai + wr) * 2 + 0) * 64 + (bj * 2 + n) * 16 + fq * 4) = acc[ai][bj][0][n];
        }
        if (fr == 15) {
#pragma unroll
            for (int ai = 0; ai < 2; ++ai)
#pragma unroll
                for (int bj = 0; bj < 2; ++bj)
#pragma unroll
                    for (int n = 0; n < 2; ++n) *(__attribute__((address_space(3))) f32x4*)(xb_ + ((2 * ai + wr) * 2 + 1) * 64 + (bj * 2 + n) * 16 + fq * 4) = acc[ai][bj][3][n];
        }
        if (wr == 0 && fr < 2) {
            bf16_t* dst = Uedge + ((size_t)u.pm * 4 + fr) * 5632 + u.pn * BM + 32 * wc + 4 * fq;
#pragma unroll
            for (int bj = 0; bj < 2; ++bj)
#pragma unroll
                for (int n = 0; n < 2; ++n) *(u32x2*)(dst + 128 * bj + 16 * n) = pk4(acc[0][bj][0][n]);
        }
        if (wr == 1 && fr >= 14) {
            bf16_t* dst = Uedge + ((size_t)u.pm * 4 + 2 + (fr - 14)) * 5632 + u.pn * BM + 32 * wc + 4 * fq;
#pragma unroll
            for (int bj = 0; bj < 2; ++bj)
#pragma unroll
                for (int n = 0; n < 2; ++n) *(u32x2*)(dst + 128 * bj + 16 * n) = pk4(acc[1][bj][3][n]);
        }
        asm volatile("s_waitcnt lgkmcnt(0)" ::: "memory"); __builtin_amdgcn_s_barrier(); asm volatile("" ::: "memory");
#pragma unroll
        for (int n = 0; n < 2; ++n) {
            const int v0 = u.pn * 128 + 32 * wc + 16 * n + 4 * fq;
            f32x4 w[2][3], bb[2];
#pragma unroll
            for (int bj = 0; bj < 2; ++bj) {
#pragma unroll
                for (int k = 0; k < 3; ++k) w[bj][k] = *(const f32x4*)(cw + k * 5632 + bj * 2816 + v0);
                bb[bj] = *(const f32x4*)(cb + bj * 2816 + v0);
            }
#pragma unroll
            for (int ai = 0; ai < 2; ++ai) {
                const int blk = 2 * ai + wr;
                f32x4 P[2], N[2];
#pragma unroll
                for (int bj = 0; bj < 2; ++bj) {
                    P[bj] = (blk > 0) ? *(const __attribute__((address_space(3))) f32x4*)(xb_ + ((blk - 1) * 2 + 1) * 64 + (bj * 2 + n) * 16 + fq * 4) : (f32x4){0.f, 0.f, 0.f, 0.f};
                    N[bj] = (blk < 3) ? *(const __attribute__((address_space(3))) f32x4*)(xb_ + ((blk + 1) * 2 + 0) * 64 + (bj * 2 + n) * 16 + fq * 4) : (f32x4){0.f, 0.f, 0.f, 0.f};
                }
#pragma unroll
                for (int m = 0; m < 4; ++m) {
                    f32x4 y[2];
#pragma unroll
                    for (int bj = 0; bj < 2; ++bj) {
                        const f32x4 x = acc[ai][bj][m][n];
                        const f32x4 rp = dpp_ror1(x), rn = dpp_ror15(x);
                        const f32x4 sp = (m > 0) ? dpp_ror1(acc[ai][bj][m > 0 ? m - 1 : 0][n]) : P[bj];
                        const f32x4 sn = (m < 3) ? dpp_ror15(acc[ai][bj][m < 3 ? m + 1 : 3][n]) : N[bj];
                        f32x4 pv, nv;
#pragma unroll
                        for (int e = 0; e < 4; ++e) { pv[e] = (fr == 0) ? sp[e] : rp[e]; nv[e] = (fr == 15) ? sn[e] : rn[e]; }
                        y[bj] = w[bj][0] * pv + w[bj][1] * x + w[bj][2] * nv + bb[bj];
                    }
                    const f32x2 g0 = gelu_pk((f32x2){y[1][0], y[1][1]}), g1 = gelu_pk((f32x2){y[1][2], y[1][3]});
                    const f32x4 o = {g0.x * y[0][0], g0.y * y[0][1], g1.x * y[0][2], g1.y * y[0][3]};
                    const int trow = ai * HALF + wr * 64 + m * 16 + fr;
                    if (trow != 0 && trow != 255) *(u32x2*)(ACT + (size_t)(u.pm * BM + trow) * 2816 + v0) = pk4(o);
                }
            }
        }
    }
};

template <class Epi, class Sched, bool ALIGN_EPI = false, bool SP2 = false>
__device__ __forceinline__ void gemm_phase(PG8_LAS unsigned char* lds, const Gemm g, const Sched& S, const Epi& E) {
    const int tid = ltid(), wid = __builtin_amdgcn_readfirstlane(tid >> 6), lane = tid & 63, wr = wid >> 2, wc = wid & 3, fr = lane & 15, fq = lane >> 4;
    const int K = g.K, LD = g.ld, nt = K / BK;
    unsigned voffA[2], voffB[2];
#pragma unroll
    for (int i = 0; i < 2; ++i) { int R, C; stage_rc(tid * 16 + i * 8192, R, C); const int Rb = Epi::PERM ? ((R & ~31) + perm32(R & 31)) : R;
        voffA[i] = (unsigned)(R * LD + C) * 2u; voffB[i] = (unsigned)(Rb * LD + C) * 2u; }
    const size_t kstep = (size_t)(BK * 2);
    const size_t hstep = (size_t)HALF * LD * 2;
    const size_t tstep = 2 * hstep;
    const unsigned ldsw = (unsigned)wid * 1024u;
    const int aoff = lds_byte(wr * 64 + fr, fq * 8), boff = lds_byte(wc * 32 + fr, fq * 8);
#define PG8_SA(b, h) (((b) * 2 + (h)) * HTB)
#define PG8_SB(b, h) ((4 + (b) * 2 + (h)) * HTB)
#define PG8_STAGE(bufoff, gbase, voff) do { _Pragma("unroll") for (int _i = 0; _i < 2; ++_i) \
        __builtin_amdgcn_global_load_lds((const unsigned*)((const char*)(gbase) + (voff)[_i]), (PG8_LAS unsigned*)(lds + (bufoff) + ldsw + _i * 8192), 16, 0, 0); } while (0)
#define PG8_LDA(dst, b, h) do { _Pragma("unroll") for (int m = 0; m < 4; ++m) _Pragma("unroll") for (int k = 0; k < 2; ++k) dst[m][k] = *(const PG8_LAS bf16x8*)(lds + PG8_SA(b, h) + aoff + m * 2048 + k * 1024); } while (0)
#define PG8_LDB(dst, b, h) do { _Pragma("unroll") for (int n = 0; n < 2; ++n) _Pragma("unroll") for (int k = 0; k < 2; ++k) dst[n][k] = *(const PG8_LAS bf16x8*)(lds + PG8_SB(b, h) + boff + n * 2048 + k * 1024); } while (0)
#define PG8_MMA(ai, bj, At, Bt) do { __builtin_amdgcn_s_setprio(1); _Pragma("unroll") for (int m = 0; m < 4; ++m) _Pragma("unroll") for (int n = 0; n < 2; ++n) _Pragma("unroll") for (int k = 0; k < 2; ++k) \
        acc[ai][bj][m][n] = __builtin_amdgcn_mfma_f32_16x16x32_bf16(Bt[n][k], At[m][k], acc[ai][bj][m][n], 0, 0, 0); __builtin_amdgcn_s_setprio(0); } while (0)
#define PG8_WAIT_V(n) asm volatile("s_waitcnt vmcnt(" #n ")" ::: "memory")
#define PG8_WAIT_L(n) asm volatile("s_waitcnt lgkmcnt(" #n ")" ::: "memory")
#define PG8_BAR __builtin_amdgcn_s_barrier()
#define PG8_SCHED __builtin_amdgcn_sched_barrier(0)
    Unit cur, nxt; int ui = 0;
    if (!S.next(0, cur)) return;
    f32x4 acc[2][2][4][2];
#pragma unroll
    for (int a = 0; a < 2; ++a)
#pragma unroll
        for (int b = 0; b < 2; ++b)
#pragma unroll
            for (int m = 0; m < 4; ++m)
#pragma unroll
                for (int n = 0; n < 2; ++n) acc[a][b][m][n] = (f32x4){0.f, 0.f, 0.f, 0.f};
    bf16x8 At[4][2], B0[2][2], B1[2][2];
    const char* cA = (const char*)g.A + (size_t)cur.pm * tstep + (size_t)cur.koff * 2; const char* cB = (const char*)g.Bt + (size_t)cur.pn * tstep + (size_t)cur.koff * 2;
    S.a_ready(cur);
    if constexpr (SP2) {
        PG8_STAGE(PG8_SB(0, 0), cB, voffB); PG8_STAGE(PG8_SB(0, 1), cB + hstep, voffB); PG8_STAGE(PG8_SA(0, 0), cA, voffA); PG8_STAGE(PG8_SA(0, 1), cA + hstep, voffA);
        if (wr == 1) PG8_BAR;
        PG8_WAIT_V(2); PG8_BAR;
        PG8_STAGE(PG8_SB(1, 0), cB + kstep, voffB); PG8_STAGE(PG8_SA(1, 0), cA + kstep, voffA); PG8_STAGE(PG8_SB(1, 1), cB + hstep + kstep, voffB);
        PG8_WAIT_V(6); PG8_BAR;
    } else {
        PG8_STAGE(PG8_SB(0, 0), cB, voffB); PG8_STAGE(PG8_SA(0, 0), cA, voffA); PG8_STAGE(PG8_SB(0, 1), cB + hstep, voffB); PG8_STAGE(PG8_SA(0, 1), cA + hstep, voffA);
        if (wr == 1) PG8_BAR;
        PG8_WAIT_V(4); PG8_BAR;
        PG8_STAGE(PG8_SB(1, 0), cB + kstep, voffB); PG8_STAGE(PG8_SA(1, 0), cA + kstep, voffA); PG8_STAGE(PG8_SB(1, 1), cB + hstep + kstep, voffB);
        PG8_WAIT_V(6); PG8_BAR;
    }
    for (;;) {
        const bool has_next = S.next(ui + 1, nxt);
        const char* nA = has_next ? (const char*)g.A + (size_t)nxt.pm * tstep + (size_t)nxt.koff * 2 : cA; const char* nB = has_next ? (const char*)g.Bt + (size_t)nxt.pn * tstep + (size_t)nxt.koff * 2 : cB;
        for (int t = 0; t < nt; t += 2) {
            const bool last = (t == nt - 2);
            const char* a1 = cA + (size_t)(t + 1) * kstep;
            const char* a2 = last ? nA : cA + (size_t)(t + 2) * kstep; const char* b2 = last ? nB : cB + (size_t)(t + 2) * kstep;
            const char* a3 = a2 + kstep; const char* b3 = b2 + kstep;
            if (last && has_next) S.a_ready(nxt);
            if constexpr (SP2) {
            PG8_LDB(B0, 0, 0); PG8_LDB(B1, 0, 1); PG8_SCHED; PG8_LDA(At, 0, 0); PG8_STAGE(PG8_SA(1, 1), a1 + hstep, voffA);
            PG8_WAIT_V(8); PG8_WAIT_L(0); PG8_BAR; PG8_MMA(0, 0, At, B0); PG8_MMA(0, 1, At, B1); PG8_BAR; PG8_SCHED;
            PG8_LDA(At, 0, 1); PG8_STAGE(PG8_SB(0, 0), b2, voffB); PG8_STAGE(PG8_SB(0, 1), b2 + hstep, voffB); PG8_STAGE(PG8_SA(0, 0), a2, voffA);
            PG8_WAIT_V(8); PG8_WAIT_L(0); PG8_BAR; PG8_MMA(1, 0, At, B0); PG8_MMA(1, 1, At, B1); PG8_BAR; PG8_SCHED;
            PG8_LDB(B0, 1, 0); PG8_LDB(B1, 1, 1); PG8_SCHED; PG8_LDA(At, 1, 0); PG8_STAGE(PG8_SA(0, 1), a2 + hstep, voffA);
            PG8_WAIT_V(8); PG8_WAIT_L(0); PG8_BAR; PG8_MMA(0, 0, At, B0); PG8_MMA(0, 1, At, B1); PG8_BAR; PG8_SCHED;
            PG8_LDA(At, 1, 1); PG8_STAGE(PG8_SB(1, 0), b3, voffB); PG8_STAGE(PG8_SB(1, 1), b3 + hstep, voffB); PG8_STAGE(PG8_SA(1, 0), a3, voffA);
            PG8_WAIT_V(8); PG8_WAIT_L(0); PG8_BAR; PG8_MMA(1, 0, At, B0); PG8_MMA(1, 1, At, B1); PG8_BAR; PG8_SCHED;
            } else {
            PG8_LDB(B0, 0, 0); PG8_SCHED; PG8_LDA(At, 0, 0); PG8_STAGE(PG8_SA(1, 1), a1 + hstep, voffA);
            PG8_WAIT_L(8); PG8_BAR; PG8_WAIT_L(0); PG8_MMA(0, 0, At, B0); PG8_BAR; PG8_SCHED;
            PG8_LDB(B1, 0, 1); PG8_STAGE(PG8_SB(0, 0), b2, voffB);
            PG8_BAR; PG8_WAIT_L(0); PG8_MMA(0, 1, At, B1); PG8_BAR;
            PG8_LDA(At, 0, 1); PG8_STAGE(PG8_SA(0, 0), a2, voffA);
            PG8_BAR; PG8_WAIT_L(0); PG8_MMA(1, 0, At, B0); PG8_BAR; PG8_SCHED;
            PG8_STAGE(PG8_SB(0, 1), b2 + hstep, voffB);
            PG8_WAIT_V(6); PG8_BAR; PG8_MMA(1, 1, At, B1); PG8_BAR;
            PG8_LDB(B0, 1, 0); PG8_SCHED; PG8_LDA(At, 1, 0); PG8_STAGE(PG8_SA(0, 1), a2 + hstep, voffA);
            PG8_WAIT_L(8); PG8_BAR; PG8_WAIT_L(0); PG8_MMA(0, 0, At, B0); PG8_BAR; PG8_SCHED;
            PG8_LDB(B1, 1, 1); PG8_STAGE(PG8_SB(1, 0), b3, voffB);
            PG8_BAR; PG8_WAIT_L(0); PG8_MMA(0, 1, At, B1); PG8_BAR;
            PG8_LDA(At, 1, 1); PG8_STAGE(PG8_SA(1, 0), a3, voffA);
            PG8_BAR; PG8_WAIT_L(0); PG8_MMA(1, 0, At, B0); PG8_BAR; PG8_SCHED;
            PG8_STAGE(PG8_SB(1, 1), b3 + hstep, voffB);
            PG8_WAIT_V(6); PG8_BAR; PG8_MMA(1, 1, At, B1); PG8_BAR;
            }
        }
        if constexpr (ALIGN_EPI) { if (wr == 0) PG8_BAR; }
        if constexpr (!Epi::AFTER_DRAIN) { E(acc, cur, wr, wc, fr, fq); S.done(cur); }
        if (!has_next) break;
        if (cur.part != 0) {
#pragma unroll
        for (int a = 0; a < 2; ++a)
#pragma unroll
            for (int b = 0; b < 2; ++b)
#pragma unroll
                for (int m = 0; m < 4; ++m)
#pragma unroll
                    for (int n = 0; n < 2; ++n) acc[a][b][m][n] = (f32x4){0.f, 0.f, 0.f, 0.f};
        }
        cur = nxt; cA = nA; cB = nB; ++ui;
        if constexpr (ALIGN_EPI) { if (wr == 1) PG8_BAR; }
    }
    PG8_WAIT_V(0);
    if constexpr (!ALIGN_EPI) { if (wr == 0) PG8_BAR; }
    PG8_BAR;
    if constexpr (Epi::AFTER_DRAIN) { E.fused(acc, cur, wr, wc, fr, fq, lds, wid, lane); S.done(cur); }
#undef PG8_SA
#undef PG8_SB
#undef PG8_STAGE
#undef PG8_LDA
#undef PG8_LDB
#undef PG8_MMA
#undef PG8_WAIT_V
#undef PG8_WAIT_L
#undef PG8_BAR
#undef PG8_SCHED
}
}

using pg8::bf16_t; using pg8::bf16x8; using pg8::f32x4; using pg8::u32x4; using pg8::u32x2; using pg8::cvt_pk_bf16; using pg8::pk4; using pg8::unpk4; using pg8::bf1;
typedef float f32x16 __attribute__((ext_vector_type(16)));
#define LAS __attribute__((address_space(3)))
typedef LAS unsigned char lds_u8;

constexpr int NT_SB = 32768;
constexpr int DM = 1024, NIN = 4352, NUP = 5632, DFF = 2816;
constexpr size_t MiB = 1u << 20;
constexpr size_t WS_TAB = 0, WS_DEC = 16384 * 2, WS_BAR = 65536;
constexpr size_t WS_WIN = 1 * MiB, WS_WAO = 18 * MiB, WS_WRO = 20 * MiB, WS_WOUT = 22 * MiB, WS_WUP = 26 * MiB, WS_WDN = 48 * MiB;
constexpr size_t WS_SS = 60 * MiB, WS_XB = 64 * MiB;
constexpr size_t WS_QA = 128 * MiB, WS_KA = 160 * MiB, WS_VAT = 168 * MiB, WS_QR = 176 * MiB, WS_KR = 192 * MiB, WS_KTF = 208 * MiB, WS_KTB = 224 * MiB,
                 WS_VRT = 240 * MiB, WS_GR = 272 * MiB, WS_GATES = 304 * MiB, WS_AO = 432 * MiB, WS_RG = 464 * MiB, WS_KV = 496 * MiB;
constexpr size_t WS_U = 128 * MiB;
constexpr size_t WS_MG = 560 * MiB, WS_RT = 624 * MiB, WS_ACT = 656 * MiB, WS_END = 832 * MiB;
constexpr int LDS_BYTES = 161024;
constexpr int LDS_RT = 132096, LDS_XCH = 144384;

__device__ __forceinline__ f32x16 mfma32(bf16x8 a, bf16x8 b, f32x16 c) { return __builtin_amdgcn_mfma_f32_32x32x16_bf16(a, b, c, 0, 0, 0); }
__device__ __forceinline__ int crow(int r, int hi) { return (r & 3) + 8 * (r >> 2) + 4 * hi; }
__device__ __forceinline__ int pi32(int r) { return (r & ~12) | ((r & 4) << 1) | ((r & 8) >> 1); }
__device__ __forceinline__ bf16x8 pack8(const f32x16& p, int b) {
    u32x4 w; w.x = cvt_pk_bf16(p[b], p[b + 1]); w.y = cvt_pk_bf16(p[b + 2], p[b + 3]); w.z = cvt_pk_bf16(p[b + 4], p[b + 5]); w.w = cvt_pk_bf16(p[b + 6], p[b + 7]);
    return __builtin_bit_cast(bf16x8, w);
}
__device__ __forceinline__ bf16x8 scale8(bf16x8 q, float s) {
    const u32x4 w = __builtin_bit_cast(u32x4, q); u32x4 o;
#pragma unroll
    for (int i = 0; i < 4; ++i) o[i] = cvt_pk_bf16(__uint_as_float(w[i] << 16) * s, __uint_as_float(w[i] & 0xffff0000u) * s);
    return __builtin_bit_cast(bf16x8, o);
}
__device__ __forceinline__ float wave_sum(float v) {
#pragma unroll
    for (int o = 1; o < 64; o <<= 1) v += __shfl_xor(v, o);
    return v;
}
__device__ __forceinline__ float wave_max(float v) {
#pragma unroll
    for (int o = 1; o < 64; o <<= 1) v = fmaxf(v, __shfl_xor(v, o));
    return v;
}

__device__ __forceinline__ int tile_in(int tp) { return (tp == 2) ? 4 : (tp == 4) ? 2 : (tp == 5) ? 10 : (tp == 10) ? 5 : tp; }
__device__ __forceinline__ int map_in(int np) { const int tl = tile_in(np >> 8), pc = np & 255; if (tl >= 5) return (tl << 8) + pc; return (tl << 8) + 64 * ((pc >> 5) & 3) + 32 * (pc >> 7) + (pc & 31); }
__device__ __forceinline__ int map_up(int np) { const int j = np >> 8, pc = np & 255; return pc < 128 ? 128 * j + pc : DFF + 128 * j + (pc - 128); }
template <int MODE> __device__ __forceinline__ void conv_item(const float* __restrict__ W, int K, int N, bf16_t* __restrict__ Wt, int ldw, const float* __restrict__ g, int item, LAS float* scr, int lane) {
    const int nkb = K >> 6, kb = item % nkb, nb = item / nkb, k0 = kb << 6, n0 = nb << 5;
    const int nn = lane & 31, np = n0 + nn, ncol = (MODE == 1) ? map_in(np) : (MODE == 2) ? map_up(np) : np;
    float wv[32];
#pragma unroll
    for (int i = 0; i < 32; ++i) wv[i] = W[(size_t)(k0 + 2 * i + (lane >> 5)) * N + ncol];
    if (g) {
#pragma unroll
        for (int i = 0; i < 32; ++i) wv[i] *= g[k0 + 2 * i + (lane >> 5)];
    }
#pragma unroll
    for (int i = 0; i < 32; ++i) scr[(2 * i + (lane >> 5)) * 33 + nn] = wv[i];
    __builtin_amdgcn_s_waitcnt(0xc07f); __builtin_amdgcn_wave_barrier();
    const int cch = lane & 7;
#pragma unroll
    for (int j = 0; j < 4; ++j) {
        const int n = (lane >> 3) + 8 * j; const LAS float* sp = scr + (8 * cch) * 33 + n;
        u32x4 o; o.x = cvt_pk_bf16(sp[0 * 33], sp[1 * 33]); o.y = cvt_pk_bf16(sp[2 * 33], sp[3 * 33]); o.z = cvt_pk_bf16(sp[4 * 33], sp[5 * 33]); o.w = cvt_pk_bf16(sp[6 * 33], sp[7 * 33]);
        *(u32x4*)(Wt + (size_t)(n0 + n) * ldw + k0 + 8 * cch) = o;
    }
    __builtin_amdgcn_s_waitcnt(0xc07f); __builtin_amdgcn_wave_barrier();
}

__device__ __forceinline__ void attn_unit(const bf16_t* __restrict__ Qa, const bf16_t* __restrict__ Ka, const bf16_t* __restrict__ Vat, bf16_t* __restrict__ AO,
                                          int seq, int kvh, int qb, int S, float negM, lds_u8* lds) {
    const int tid = ltid(), lane = tid & 63, w = __builtin_amdgcn_readfirstlane(tid >> 6), r32 = lane & 31, hi = lane >> 5;
    const int head = kvh * 4 + (w >> 1);
    const size_t tq = (size_t)seq * S + qb * 128 + (w & 1) * 64;
    bf16x8 qr[2][4];
#pragma unroll
    for (int qi = 0; qi < 2; ++qi)
#pragma unroll
        for (int d0 = 0; d0 < 4; ++d0) qr[qi][d0] = *(const bf16x8*)(Qa + (tq + qi * 32 + r32) * 512 + head * 64 + d0 * 16 + hi * 8);
    f32x16 o[2][2];
#pragma unroll
    for (int qi = 0; qi < 2; ++qi)
#pragma unroll
        for (int db = 0; db < 2; ++db)
#pragma unroll
            for (int r = 0; r < 16; ++r) o[qi][db][r] = 0.f;
    float lsum[2] = {0.f, 0.f};
    const bf16_t* Kg = Ka + (size_t)seq * S * 128 + kvh * 64;
    const bf16_t* Vg = Vat + ((size_t)(seq * 2 + kvh) * 64) * S;
    const int sr = tid >> 3, sc = (tid & 7) * 8;
    constexpr int ROWB = 144, TILEB = 64 * ROWB;
    lds_u8* Kl = lds; lds_u8* Vl = lds + 2 * TILEB;
    const int NT = S >> 6;
    u32x4 kreg = *(const u32x4*)(Kg + (size_t)sr * 128 + sc);
    u32x4 vreg = *(const u32x4*)(Vg + (size_t)sr * S + sc);
    *(LAS u32x4*)(Kl + sr * ROWB + sc * 2) = kreg; *(LAS u32x4*)(Vl + sr * ROWB + sc * 2) = vreg;
    __syncthreads();
    const int pr = pi32(r32);
    if (w >= 4) __builtin_amdgcn_s_setprio(1);
    f32x16 negm;
#pragma unroll
    for (int r = 0; r < 16; ++r) negm[r] = negM;
    asm volatile("" : "+v"(negm));
#pragma unroll 1
    for (int t = 0; t < NT; ++t) {
        const int cur = t & 1;
        if (t + 1 < NT) { kreg = *(const u32x4*)(Kg + (size_t)((t + 1) * 64 + sr) * 128 + sc); vreg = *(const u32x4*)(Vg + (size_t)sr * S + (t + 1) * 64 + sc); }
        const lds_u8* Kc = Kl + cur * TILEB; const lds_u8* Vc = Vl + cur * TILEB;
        bf16x8 pa[2][4];
#pragma unroll
        for (int kb = 0; kb < 2; ++kb) {
            bf16x8 kf[4];
#pragma unroll
            for (int d0 = 0; d0 < 4; ++d0) kf[d0] = *(const LAS bf16x8*)(Kc + (kb * 32 + pr) * ROWB + d0 * 32 + hi * 16);
#pragma unroll
            for (int qi = 0; qi < 2; ++qi) {
                f32x16 p = mfma32(kf[0], qr[qi][0], negm);
#pragma unroll
                for (int d0 = 1; d0 < 4; ++d0) p = mfma32(kf[d0], qr[qi][d0], p);
#pragma unroll
                for (int r = 0; r < 16; ++r) p[r] = __builtin_amdgcn_exp2f(p[r]);
                pg8::f32x2 s2 = {p[0], p[1]};
#pragma unroll
                for (int r = 2; r < 16; r += 2) s2 += (pg8::f32x2){p[r], p[r + 1]};
                lsum[qi] += s2.x + s2.y;
                pa[qi][2 * kb] = pack8(p, 0); pa[qi][2 * kb + 1] = pack8(p, 8);
            }
        }
#pragma unroll
        for (int ks = 0; ks < 4; ++ks) {
            const bf16x8 v0 = *(const LAS bf16x8*)(Vc + r32 * ROWB + ks * 32 + hi * 16);
            const bf16x8 v1 = *(const LAS bf16x8*)(Vc + (32 + r32) * ROWB + ks * 32 + hi * 16);
#pragma unroll
            for (int qi = 0; qi < 2; ++qi) { o[qi][0] = mfma32(pa[qi][ks], v0, o[qi][0]); o[qi][1] = mfma32(pa[qi][ks], v1, o[qi][1]); }
        }
        if (t + 1 < NT) { *(LAS u32x4*)(Kl + (cur ^ 1) * TILEB + sr * ROWB + sc * 2) = kreg; *(LAS u32x4*)(Vl + (cur ^ 1) * TILEB + sr * ROWB + sc * 2) = vreg; }
        __syncthreads();
    }
    __builtin_amdgcn_s_setprio(0);
    LAS float* wsf = (LAS float*)(lds + 36864) + w * 64;
    lds_u8* stg = lds + w * 4608;
#pragma unroll
    for (int qi = 0; qi < 2; ++qi) { float l = lsum[qi]; l += __shfl_xor(l, 32); if (hi == 0) wsf[qi * 32 + r32] = l; }
    __builtin_amdgcn_s_waitcnt(0xc07f);
    __builtin_amdgcn_wave_barrier();
#pragma unroll
    for (int qi = 0; qi < 2; ++qi) {
#pragma unroll
        for (int r = 0; r < 16; ++r) {
            const int q = crow(r, hi); const float inv = 1.0f / wsf[qi * 32 + q];
            *(LAS bf16_t*)(stg + q * 144 + r32 * 2) = bf1(o[qi][0][r] * inv); *(LAS bf16_t*)(stg + q * 144 + (32 + r32) * 2) = bf1(o[qi][1][r] * inv);
        }
        __builtin_amdgcn_s_waitcnt(0xc07f);
        __builtin_amdgcn_wave_barrier();
#pragma unroll
        for (int i = 0; i < 4; ++i) {
            const int row = i * 8 + (lane >> 3), ch = lane & 7;
            const u32x4 yv = *(const LAS u32x4*)(stg + row * 144 + ch * 16);
            *(u32x4*)(AO + (tq + qi * 32 + row) * 1024 + head * 64 + ch * 8) = yv;
        }
        __builtin_amdgcn_s_waitcnt(0xc07f);
        __builtin_amdgcn_wave_barrier();
    }
    __syncthreads();
}

constexpr int R1_VT = 0, R1_KF = 34816, R1_KB = 52224, R1_BYTES = 69632;
struct R1Regs { u32x4 v[4], kf[2], kb[2]; };
__device__ __forceinline__ void r1_load(R1Regs& g, const bf16_t* __restrict__ Vrt, const bf16_t* __restrict__ Ktf, const bf16_t* __restrict__ Ktb, int u, int S, int sshift, int tid) {
    const int chunk = u >> 2, h = u & 3, t0 = chunk * 128, seq = t0 >> sshift, s0 = t0 & (S - 1);
#pragma unroll
    for (int i = 0; i < 4; ++i) { const int id = tid + i * 512, row = id >> 4, cc = (id & 15) * 8; g.v[i] = *(const u32x4*)(Vrt + ((size_t)(seq * 4 + h) * 128 + row) * S + s0 + cc); }
#pragma unroll
    for (int i = 0; i < 2; ++i) { const int id = tid + i * 512, row = id >> 4, cc = (id & 15) * 8; const size_t o = ((size_t)(seq * 4 + h) * 64 + row) * S + s0 + cc;
        g.kf[i] = *(const u32x4*)(Ktf + o); g.kb[i] = *(const u32x4*)(Ktb + o); }
}
__device__ __forceinline__ void r1_phase(const bf16_t* __restrict__ Vrt, const bf16_t* __restrict__ Ktf, const bf16_t* __restrict__ Ktb, float* __restrict__ KV, int S, int sshift, int G, int bx, lds_u8* lds) {
    const int tid = ltid(), lane = tid & 63, w = __builtin_amdgcn_readfirstlane(tid >> 6), r32 = lane & 31, hi = lane >> 5;
    const int dir = w & 1, dvb = w >> 1;
    const int NU = (NT_SB / 128) * 4;
    R1Regs g;
    int u = bx;
    if (u < NU) r1_load(g, Vrt, Ktf, Ktb, u, S, sshift, tid);
#pragma unroll 1
    for (; u < NU; u += G) {
        const int chunk = u >> 2, h = u & 3;
#pragma unroll
        for (int i = 0; i < 4; ++i) { const int id = tid + i * 512, row = id >> 4, cb = (id & 15) * 16; *(LAS u32x4*)(lds + R1_VT + row * 272 + cb) = g.v[i]; }
#pragma unroll
        for (int i = 0; i < 2; ++i) { const int id = tid + i * 512, row = id >> 4, cb = (id & 15) * 16; *(LAS u32x4*)(lds + R1_KF + row * 272 + cb) = g.kf[i]; *(LAS u32x4*)(lds + R1_KB + row * 272 + cb) = g.kb[i]; }
        __syncthreads();
        if (u + G < NU) r1_load(g, Vrt, Ktf, Ktb, u + G, S, sshift, tid);
        f32x16 acc[2];
#pragma unroll
        for (int b = 0; b < 2; ++b)
#pragma unroll
            for (int r = 0; r < 16; ++r) acc[b][r] = 0.f;
        const lds_u8* Kt = lds + (dir ? R1_KB : R1_KF);
#pragma unroll
        for (int ks = 0; ks < 8; ++ks) {
            const bf16x8 va = *(const LAS bf16x8*)(lds + R1_VT + (dvb * 32 + r32) * 272 + ks * 32 + hi * 16);
#pragma unroll
            for (int b = 0; b < 2; ++b) { const bf16x8 kb = *(const LAS bf16x8*)(Kt + (b * 32 + r32) * 272 + ks * 32 + hi * 16); acc[b] = mfma32(va, kb, acc[b]); }
        }
        float* out = KV + ((size_t)(chunk * 4 + h) * 2 + dir) * 8192;
#pragma unroll
        for (int b = 0; b < 2; ++b)
#pragma unroll
            for (int r = 0; r < 16; ++r) out[(dvb * 32 + crow(r, hi)) * 64 + b * 32 + r32] = acc[b][r];
        __syncthreads();
    }
}

constexpr int R3_KT = 0, R3_QT = 18432, R3_VT = 36864, R3_RF = 71680, R3_RB = 90112, R3_PART = 108544, R3_BYTES = 109568;
struct R3Regs { u32x4 k[2], q[2], v[4], rf[2], rb[2]; };
__device__ __forceinline__ void r3_load(R3Regs& g, const bf16_t* __restrict__ Qr, const bf16_t* __restrict__ Kr, const bf16_t* __restrict__ Vrt, const bf16_t* __restrict__ RT, int u, int S, int sshift, int tid) {
    const int chunk = u >> 2, h = u & 3, t0 = chunk * 128, seq = t0 >> sshift, s0 = t0 & (S - 1);
#pragma unroll
    for (int i = 0; i < 2; ++i) { const int id = tid + i * 512, row = id >> 3, cc = (id & 7) * 8;
        g.k[i] = *(const u32x4*)(Kr + (size_t)(t0 + row) * 256 + h * 64 + cc); g.q[i] = *(const u32x4*)(Qr + (size_t)(t0 + row) * 256 + h * 64 + cc);
        g.rf[i] = *(const u32x4*)(RT + ((size_t)(chunk * 4 + h) * 2) * 8192 + id * 8); g.rb[i] = *(const u32x4*)(RT + ((size_t)(chunk * 4 + h) * 2 + 1) * 8192 + id * 8); }
#pragma unroll
    for (int i = 0; i < 4; ++i) { const int id = tid + i * 512, row = id >> 4, cc = (id & 15) * 8;
        g.v[i] = *(const u32x4*)(Vrt + ((size_t)(seq * 4 + h) * 128 + row) * S + s0 + cc); }
}
__device__ __forceinline__ void r3_stage(const R3Regs& g, lds_u8* lds, int tid) {
#pragma unroll
    for (int i = 0; i < 2; ++i) { const int id = tid + i * 512, row = id >> 3, cb = (id & 7) * 16;
        *(LAS u32x4*)(lds + R3_KT + row * 144 + cb) = g.k[i]; *(LAS u32x4*)(lds + R3_QT + row * 144 + cb) = g.q[i];
        *(LAS u32x4*)(lds + R3_RF + row * 144 + cb) = g.rf[i]; *(LAS u32x4*)(lds + R3_RB + row * 144 + cb) = g.rb[i]; }
#pragma unroll
    for (int i = 0; i < 4; ++i) { const int id = tid + i * 512, row = id >> 4, cb = (id & 15) * 16; *(LAS u32x4*)(lds + R3_VT + row * 272 + cb) = g.v[i]; }
}
__device__ __forceinline__ void r3_phase(const bf16_t* __restrict__ Qr, const bf16_t* __restrict__ Kr, const bf16_t* __restrict__ Vrt, const bf16_t* __restrict__ RT,
                                         const bf16_t* __restrict__ Gr, bf16_t* __restrict__ RG, const float* __restrict__ dec2, int S, int sshift, int G, int bx, lds_u8* lds) {
    const int tid = ltid(), lane = tid & 63, w = __builtin_amdgcn_readfirstlane(tid >> 6), r32 = lane & 31, hi = lane >> 5;
    const int qblk = w >> 1, dvh = w & 1;
    const int NU = (NT_SB / 128) * 4;
    R3Regs g;
    int u = bx;
    if (u < NU) r3_load(g, Qr, Kr, Vrt, RT, u, S, sshift, tid);
    const int pr = pi32(r32);
#pragma unroll 1
    for (; u < NU; u += G) {
        const int chunk = u >> 2, h = u & 3, t0 = chunk * 128;
        const float lf2 = dec2[h], lb2 = dec2[4 + h];
        r3_stage(g, lds, tid);
        __syncthreads();
        if (u + G < NU) r3_load(g, Qr, Kr, Vrt, RT, u + G, S, sshift, tid);
        const int iq = qblk * 32 + r32;
        bf16x8 qraw[4];
#pragma unroll
        for (int d0 = 0; d0 < 4; ++d0) qraw[d0] = *(const LAS bf16x8*)(lds + R3_QT + iq * 144 + d0 * 32 + hi * 16);
        const float sf = __builtin_amdgcn_exp2f(lf2 * (float)(iq + 1)), sb = __builtin_amdgcn_exp2f(lb2 * (float)(128 - iq));
        f32x16 acc[2];
#pragma unroll
        for (int a = 0; a < 2; ++a)
#pragma unroll
            for (int r = 0; r < 16; ++r) acc[a][r] = 0.f;
#pragma unroll
        for (int d0 = 0; d0 < 4; ++d0) {
            const bf16x8 qf = scale8(qraw[d0], sf), qb = scale8(qraw[d0], sb);
#pragma unroll
            for (int a = 0; a < 2; ++a) {
                const int dv = dvh * 64 + a * 32 + r32;
                const bf16x8 rf = *(const LAS bf16x8*)(lds + R3_RF + dv * 144 + d0 * 32 + hi * 16);
                const bf16x8 rb = *(const LAS bf16x8*)(lds + R3_RB + dv * 144 + d0 * 32 + hi * 16);
                acc[a] = mfma32(qf, rf, acc[a]); acc[a] = mfma32(qb, rb, acc[a]);
            }
        }
#pragma unroll
        for (int kb = 0; kb < 4; ++kb) {
            f32x16 st;
#pragma unroll
            for (int r = 0; r < 16; ++r) st[r] = 0.f;
#pragma unroll
            for (int d0 = 0; d0 < 4; ++d0) {
                const bf16x8 kf = *(const LAS bf16x8*)(lds + R3_KT + (kb * 32 + pr) * 144 + d0 * 32 + hi * 16);
                st = mfma32(kf, qraw[d0], st);
            }
#pragma unroll
            for (int r = 0; r < 16; ++r) {
                const int j = kb * 32 + 16 * (r >> 3) + 8 * hi + (r & 7);
                const float dd = (float)(iq - j);
                const float e = (dd >= 0.f) ? lf2 * dd : -lb2 * dd;
                st[r] *= __builtin_amdgcn_exp2f(e);
            }
            bf16x8 pa[2]; pa[0] = pack8(st, 0); pa[1] = pack8(st, 8);
#pragma unroll
            for (int s = 0; s < 2; ++s)
#pragma unroll
                for (int a = 0; a < 2; ++a) {
                    const bf16x8 vf = *(const LAS bf16x8*)(lds + R3_VT + (dvh * 64 + a * 32 + r32) * 272 + kb * 64 + s * 32 + hi * 16);
                    acc[a] = mfma32(pa[s], vf, acc[a]);
                }
        }
        LAS float* part = (LAS float*)(lds + R3_PART);
        float ssq[16];
#pragma unroll
        for (int r = 0; r < 16; ++r) {
            float q = acc[0][r] * acc[0][r] + acc[1][r] * acc[1][r];
            q += __shfl_xor(q, 1); q += __shfl_xor(q, 2); q += __shfl_xor(q, 4); q += __shfl_xor(q, 8); q += __shfl_xor(q, 16);
            ssq[r] = q;
            if (r32 == 0) part[(qblk * 2 + dvh) * 32 + crow(r, hi)] = q;
        }
        __syncthreads();
        lds_u8* stg = lds + w * 4608;
#pragma unroll
        for (int r = 0; r < 16; ++r) {
            const int qrow = crow(r, hi);
            const float tot = ssq[r] + part[(qblk * 2 + (dvh ^ 1)) * 32 + qrow];
            const float inv = rsqrtf(tot * (1.0f / 128.0f) + EPS_F);
#pragma unroll
            for (int a = 0; a < 2; ++a) *(LAS bf16_t*)(stg + qrow * 144 + (a * 32 + r32) * 2) = bf1(acc[a][r] * inv);
        }
        __builtin_amdgcn_s_waitcnt(0xc07f);
        __builtin_amdgcn_wave_barrier();
#pragma unroll
        for (int i = 0; i < 4; ++i) {
            const int row = i * 8 + (lane >> 3), ch = lane & 7;
            const u32x4 yv = *(const LAS u32x4*)(stg + row * 144 + ch * 16);
            const size_t o = (size_t)(t0 + qblk * 32 + row) * 512 + h * 128 + dvh * 64 + ch * 8;
            const u32x4 gv = *(const u32x4*)(Gr + o);
            u32x4 ov;
#pragma unroll
            for (int e = 0; e < 4; ++e) ov[e] = cvt_pk_bf16(__uint_as_float(yv[e] << 16) * __uint_as_float(gv[e] << 16), __uint_as_float(yv[e] & 0xffff0000u) * __uint_as_float(gv[e] & 0xffff0000u));
            *(u32x4*)(RG + (size_t)(t0 + qblk * 32 + row) * 1024 + 512 + h * 128 + dvh * 64 + ch * 8) = ov;
        }
        __syncthreads();
    }
}

#define XB_TMO      128
#define XB_XCNT(j)  (256  + 64 * (j))
#define XB_XSUB(j)  (1280 + 64 * (j))
#define XB_XGEN(j)  (2304 + 64 * (j))
#define XB_TOP      3328
#define XB_TOPGEN   3392
#define XCD_BAR_WORDS 3456
#define XB_SPIN_CAP (1u << 18)

__device__ __forceinline__ unsigned xb_ld(unsigned* p)              { return __hip_atomic_load(p, __ATOMIC_RELAXED, __HIP_MEMORY_SCOPE_AGENT); }
__device__ __forceinline__ unsigned xb_add(unsigned* p, unsigned v) { return __hip_atomic_fetch_add(p, v, __ATOMIC_RELAXED, __HIP_MEMORY_SCOPE_AGENT); }
__device__ __forceinline__ unsigned xb_xcc_id() { return (unsigned)__builtin_amdgcn_s_getreg((3 << 11) | 20) & 0xFu; }
#define XB_SPIN(cond, bar) do { unsigned _sp = 0; while (cond) { __builtin_amdgcn_s_sleep(1); \
    if ((++_sp & 255u) == 0u) { if (xb_ld(&(bar)[XB_TMO])) break; if (_sp > XB_SPIN_CAP) { atomicAdd(&(bar)[XB_TMO], 1u); break; } } } } while (0)

struct XcdBarrier {
    unsigned* bar; unsigned x;
    volatile LAS unsigned* st;
};

__device__ __forceinline__ XcdBarrier xcd_barrier_post(unsigned* bar, volatile LAS unsigned* st) {
    XcdBarrier b; b.bar = bar; b.x = xb_xcc_id(); b.st = st;
    if (threadIdx.x == 0) (void)xb_add(&bar[XB_XCNT(b.x)], 1u);
    return b;
}
__device__ __forceinline__ void xcd_barrier_complete(unsigned* bar, unsigned x, unsigned& nloc, unsigned& nx) {
    const unsigned G = gridDim.x * gridDim.y * gridDim.z;
    unsigned sum, cnt, mine, sp = 0u;
    for (;;) {
        sum = 0u; cnt = 0u; mine = 0u;
#pragma unroll
        for (unsigned j = 0; j < 16; ++j) { const unsigned c = xb_ld(&bar[XB_XCNT(j)]); sum += c; cnt += (c > 0u) ? 1u : 0u; mine = (j == x) ? c : mine; }
        if (sum == G) break;
        __builtin_amdgcn_s_sleep(1);
        if ((++sp & 255u) == 0u) { if (xb_ld(&bar[XB_TMO])) break; if (sp > XB_SPIN_CAP) { atomicAdd(&bar[XB_TMO], 1u); break; } }
    }
    nloc = mine > 0u ? mine : 1u; nx = cnt > 0u ? cnt : 1u;
}

__device__ __forceinline__ void xcd_barrier(const XcdBarrier& b) {
    asm volatile("s_waitcnt vmcnt(0)" ::: "memory");
    __syncthreads();
    if (threadIdx.x == 0) {
        unsigned* bar = b.bar;
        __builtin_amdgcn_s_waitcnt(0);
        unsigned nloc = b.st[0], nx = b.st[1];
        if (nloc == 0u) { xcd_barrier_complete(bar, b.x, nloc, nx); b.st[0] = nloc; b.st[1] = nx; }
        const unsigned old = xb_add(&bar[XB_XSUB(b.x)], 1u);
        const unsigned gen = old / nloc;
        if (old + 1u == (gen + 1u) * nloc) {
            __builtin_amdgcn_fence(__ATOMIC_RELEASE, "agent");
            asm volatile("s_waitcnt vmcnt(0)" ::: "memory");
            const unsigned og = xb_add(&bar[XB_TOP], 1u);
            const unsigned tg = og / nx;
            if (og + 1u == (tg + 1u) * nx) xb_add(&bar[XB_TOPGEN], 1u);
            else XB_SPIN(xb_ld(&bar[XB_TOPGEN]) == tg, bar);
            __builtin_amdgcn_fence(__ATOMIC_ACQUIRE, "agent");
            xb_add(&bar[XB_XGEN(b.x)], 1u);
            asm volatile("s_waitcnt vmcnt(0)" ::: "memory");
        } else {
            XB_SPIN(xb_ld(&bar[XB_XGEN(b.x)]) == gen, bar);
            __builtin_amdgcn_fence(__ATOMIC_ACQUIRE, "agent");
            asm volatile("s_waitcnt vmcnt(0)" ::: "memory");
        }
    }
    __syncthreads();
}

struct Args { const float* in[17]; float* out; unsigned char* ws; };
typedef __attribute__((address_space(4))) const Args CArgs;
__device__ __forceinline__ CArgs* kargs() { CArgs* p = (CArgs*)__builtin_amdgcn_kernarg_segment_ptr(); asm volatile("" : "+s"(p)); return p; }
#define WSP(T, off) ((T*)(ws + (off)))

__global__ void __launch_bounds__(512, 2) fwd_megakernel(Args a_unused) {
    extern __shared__ __attribute__((aligned(16))) unsigned char lds_raw[];
    cg::grid_group grid = cg::this_grid();
    lds_u8* lds = (lds_u8*)lds_raw;
    const int G = gridDim.x, bx = blockIdx.x;
    XcdBarrier bar;
    {
        volatile LAS unsigned* st = (volatile LAS unsigned*)(lds + 131072);
        if (threadIdx.x < 2) st[threadIdx.x] = 0u;
        __syncthreads();
        CArgs* A = kargs(); bar = xcd_barrier_post((unsigned*)(A->ws + WS_BAR), st);
    }
    if (gridDim.x == 0x7fffffffu) grid.sync();

    {
        CArgs* A = kargs(); unsigned char* ws = A->ws; const int tid = ltid(), lane = tid & 63, wave = __builtin_amdgcn_readfirstlane(tid >> 6); (void)lane; (void)wave;
        if (bx == 0) {
            float* decs = WSP(float, WS_DEC);
            if (tid < 16) { const int l = tid >> 3, j = tid & 7; const float x = (j < 4) ? A->in[6][l * 4 + j] : A->in[7][l * 4 + j - 4];
                decs[tid] = -log1pf(expf(-x)) * 1.4426950408889634f; }
        }
        LAS float* scr = (LAS float*)lds + wave * (64 * 33);
        constexpr int I_IN = 16 * 136, I_AO = 8 * 32, I_OUT = 16 * 32, I_UP = 16 * 176, I_DN = 44 * 32, I_L = I_IN + 2 * I_AO + I_OUT + I_UP + I_DN;
#pragma unroll 1
        for (int it = bx * 8 + wave; it < 2 * I_L; it += G * 8) {
            const int l = it / I_L; int r = it % I_L;
            if (r < I_IN) { conv_item<1>(A->in[3] + (size_t)l * DM * NIN, DM, NIN, WSP(bf16_t, WS_WIN) + (size_t)l * NIN * DM, DM, A->in[2] + l * DM, r, scr, lane); continue; } r -= I_IN;
            if (r < I_AO) { conv_item<0>(A->in[8] + (size_t)l * 512 * DM, 512, DM, WSP(bf16_t, WS_WAO) + (size_t)l * DM * DM, DM, nullptr, r, scr, lane); continue; } r -= I_AO;
            if (r < I_AO) { conv_item<0>(A->in[9] + (size_t)l * 512 * DM, 512, DM, WSP(bf16_t, WS_WAO) + (size_t)l * DM * DM + 512, DM, nullptr, r, scr, lane); continue; } r -= I_AO;
            if (r < I_OUT) { conv_item<0>(A->in[11] + (size_t)l * DM * DM, DM, DM, WSP(bf16_t, WS_WOUT) + (size_t)l * DM * DM, DM, nullptr, r, scr, lane); continue; } r -= I_OUT;
            if (r < I_UP) { conv_item<2>(A->in[13] + (size_t)l * DM * NUP, DM, NUP, WSP(bf16_t, WS_WUP) + (size_t)l * NUP * DM, DM, A->in[12] + l * DM, r, scr, lane); continue; } r -= I_UP;
            conv_item<0>(A->in[16] + (size_t)l * DFF * DM, DFF, DM, WSP(bf16_t, WS_WDN) + (size_t)l * DM * DFF, DFF, nullptr, r, scr, lane);
        }
    }

#pragma unroll 1
    for (int sb = 0; sb < 3; ++sb) {
        {
            CArgs* A = kargs(); unsigned char* ws = A->ws; const int tid = ltid(), lane = tid & 63, wave = __builtin_amdgcn_readfirstlane(tid >> 6); (void)lane; (void)wave;
            const float* xin = (sb == 0) ? A->in[0] : A->in[1] + (size_t)(sb - 1) * NT_SB * DM;
            bf16_t* xb = WSP(bf16_t, WS_XB); float* ss = WSP(float, WS_SS);
            const int gw = bx * 8 + wave, NGW = G * 8;
#pragma unroll 1
            for (int row = gw; row < NT_SB; row += 4 * NGW) {
                f32x4 v[4][4]; float q[4];
#pragma unroll
                for (int rr = 0; rr < 4; ++rr) { const int r1 = (row + rr * NGW < NT_SB) ? row + rr * NGW : row; const f32x4* xr = (const f32x4*)(xin + (size_t)r1 * DM) + lane;
#pragma unroll
                    for (int j = 0; j < 4; ++j) v[rr][j] = xr[64 * j]; }
#pragma unroll
                for (int rr = 0; rr < 4; ++rr) { float qq = 0.f;
#pragma unroll
                    for (int j = 0; j < 4; ++j) qq += (v[rr][j][0] * v[rr][j][0] + v[rr][j][1] * v[rr][j][1]) + (v[rr][j][2] * v[rr][j][2] + v[rr][j][3] * v[rr][j][3]);
                    q[rr] = wave_sum(qq); }
#pragma unroll
                for (int rr = 0; rr < 4; ++rr) { const int r2 = row + rr * NGW; if (r2 >= NT_SB) continue;
                    u32x2* o8 = (u32x2*)(xb + (size_t)r2 * DM) + lane;
#pragma unroll
                    for (int j = 0; j < 4; ++j) o8[64 * j] = pk4(v[rr][j]);
                    if (lane < 16) ss[(size_t)r2 * 16 + lane] = (lane == 0) ? q[rr] : 0.f; }
            }
        }
        xcd_barrier(bar);
#pragma unroll 1
        for (int l = 0; l < 2; ++l) {
            {
                CArgs* A = kargs(); unsigned char* ws = A->ws; const int tid = ltid(), lane = tid & 63, wave = __builtin_amdgcn_readfirstlane(tid >> 6); (void)lane; (void)wave;
                const int S = (sb == 0) ? 8192 : 2048, sshift = (sb == 0) ? 13 : 11;
                pg8::Gemm g{WSP(bf16_t, WS_XB), WSP(bf16_t, WS_WIN) + (size_t)l * NIN * DM, NT_SB, NIN, DM, DM}; pg8::StaticOrder So; So.init(NT_SB, NIN, G, bx);
                pg8::rstd_table(WSP(float, WS_SS), So, (LAS float*)(lds + LDS_RT));
                pg8::EpiIn E{(pg8::lds_cf*)(lds + LDS_RT), A->in[4] + l * 64, A->in[5] + l * 64, A->in[10] + l * 2048, WSP(float, WS_DEC) + l * 8,
                             WSP(bf16_t, WS_QA), WSP(bf16_t, WS_KA), WSP(bf16_t, WS_VAT), WSP(bf16_t, WS_QR), WSP(bf16_t, WS_KR), WSP(bf16_t, WS_KTF), WSP(bf16_t, WS_KTB),
                             WSP(bf16_t, WS_VRT), WSP(bf16_t, WS_GR), WSP(bf16_t, WS_GATES), S, sshift};
                pg8::gemm_phase<pg8::EpiIn, pg8::StaticOrder, true, true>(lds, g, So, E);
            }
            xcd_barrier(bar);
            {
                CArgs* A = kargs(); unsigned char* ws = A->ws; const int tid = ltid(), lane = tid & 63, wave = __builtin_amdgcn_readfirstlane(tid >> 6); (void)lane; (void)wave;
                const int S = (sb == 0) ? 8192 : 2048, sshift = (sb == 0) ? 13 : 11;
                const float mq = wave_max(fabsf(A->in[4][l * 64 + lane])), mk = wave_max(fabsf(A->in[5][l * 64 + lane]));
                const float negM = -11.541560327111707f * mq * mk;
                const int nq = S >> 7, nunits = (NT_SB / S) * 2 * nq;
                const bool xl = (G % 8 == 0) && ((nunits / nq) % 8 == 0);
#pragma unroll 1
                for (int u0 = bx; u0 < nunits; u0 += G) {
                    int u = u0;
                    if (xl) { const int m = (bx >> 3) + (G >> 3) * (u0 / G), gpx = (nunits / nq) >> 3; u = ((bx & 7) * gpx + m / nq) * nq + (m % nq); }
                    const int qb = u % nq, kvh = (u / nq) & 1, seq = u / (2 * nq);
                    attn_unit(WSP(bf16_t, WS_QA), WSP(bf16_t, WS_KA), WSP(bf16_t, WS_VAT), WSP(bf16_t, WS_AO), seq, kvh, qb, S, negM, lds);
                }
                r1_phase(WSP(bf16_t, WS_VRT), WSP(bf16_t, WS_KTF), WSP(bf16_t, WS_KTB), WSP(float, WS_KV), S, sshift, G, bx, lds);
            }
            xcd_barrier(bar);
            {
                CArgs* A = kargs(); unsigned char* ws = A->ws; const int tid = ltid(), lane = tid & 63, wave = __builtin_amdgcn_readfirstlane(tid >> 6); (void)lane; (void)wave;
                const int S = (sb == 0) ? 8192 : 2048;
                const float* dec2 = WSP(float, WS_DEC) + l * 8; const float* KV = WSP(float, WS_KV); bf16_t* RT = WSP(bf16_t, WS_RT);
                const int nc = S >> 7, nscan = (NT_SB / S) * 8 * 8192;
#pragma unroll 1
                for (int idx = bx * 512 + tid; idx < nscan; idx += G * 512) {
                    const int e = idx & 8191, rest = idx >> 13, dir = rest & 1, h = (rest >> 1) & 3, seq = rest >> 3;
                    const float dC = exp2f(dec2[dir * 4 + h] * 128.0f);
                    const size_t base = ((size_t)(seq * nc) * 4 + h) * 2 + dir;
                    float R = 0.f;
#pragma unroll 1
                    for (int cb = 0; cb < nc; cb += 16) {
                        float kv[16];
#pragma unroll
                        for (int i = 0; i < 16; ++i) { const int c = dir ? (nc - 1 - cb - i) : (cb + i); kv[i] = KV[(base + (size_t)c * 8) * 8192 + e]; }
#pragma unroll
                        for (int i = 0; i < 16; ++i) { const int c = dir ? (nc - 1 - cb - i) : (cb + i); RT[(base + (size_t)c * 8) * 8192 + e] = bf1(R); R = dC * R + kv[i]; }
                    }
                }
            }
            xcd_barrier(bar);
            {
                CArgs* A = kargs(); unsigned char* ws = A->ws; const int tid = ltid(), lane = tid & 63, wave = __builtin_amdgcn_readfirstlane(tid >> 6); (void)lane; (void)wave;
                const int S = (sb == 0) ? 8192 : 2048, sshift = (sb == 0) ? 13 : 11;
                r3_phase(WSP(bf16_t, WS_QR), WSP(bf16_t, WS_KR), WSP(bf16_t, WS_VRT), WSP(bf16_t, WS_RT), WSP(bf16_t, WS_GR), WSP(bf16_t, WS_AO), WSP(float, WS_DEC) + l * 8, S, sshift, G, bx, lds);
            }
            xcd_barrier(bar);
            {
                CArgs* A = kargs(); unsigned char* ws = A->ws; const int tid = ltid(), lane = tid & 63, wave = __builtin_amdgcn_readfirstlane(tid >> 6); (void)lane; (void)wave;
                pg8::PairOrder So; So.init(NT_SB, DM, G, bx, 512);
                pg8::Gemm g{WSP(bf16_t, WS_AO), WSP(bf16_t, WS_WAO) + (size_t)l * DM * DM, NT_SB, DM, 512, DM}; pg8::EpiMergeF E{WSP(bf16_t, WS_GATES), WSP(bf16_t, WS_MG)};
                pg8::gemm_phase<pg8::EpiMergeF, pg8::PairOrder, true, true>(lds, g, So, E);
            }
            xcd_barrier(bar);
            {
                CArgs* A = kargs(); unsigned char* ws = A->ws; const int tid = ltid(), lane = tid & 63, wave = __builtin_amdgcn_readfirstlane(tid >> 6); (void)lane; (void)wave;
                pg8::Gemm g{WSP(bf16_t, WS_MG), WSP(bf16_t, WS_WOUT) + (size_t)l * DM * DM, NT_SB, DM, DM, DM}; pg8::StaticOrder So; So.init(NT_SB, DM, G, bx);
                pg8::EpiResid<false> E{WSP(bf16_t, WS_XB), nullptr, WSP(float, WS_SS)};
                pg8::gemm_phase<pg8::EpiResid<false>, pg8::StaticOrder, true, true>(lds, g, So, E);
            }
            xcd_barrier(bar);
            {
                CArgs* A = kargs(); unsigned char* ws = A->ws; const int tid = ltid(), lane = tid & 63, wave = __builtin_amdgcn_readfirstlane(tid >> 6); (void)lane; (void)wave;
                pg8::Gemm g{WSP(bf16_t, WS_XB), WSP(bf16_t, WS_WUP) + (size_t)l * NUP * DM, NT_SB, NUP, DM, DM}; pg8::StaticOrder So; So.init(NT_SB, NUP, G, bx);
                pg8::rstd_table(WSP(float, WS_SS), So, (LAS float*)(lds + LDS_RT));
                pg8::EpiUpConv E{(pg8::lds_cf*)(lds + LDS_RT), (pg8::lds_f*)(lds + LDS_XCH), A->in[14] + (size_t)l * 3 * NUP, A->in[15] + (size_t)l * NUP, WSP(bf16_t, WS_ACT), WSP(bf16_t, WS_U)};
                pg8::gemm_phase<pg8::EpiUpConv, pg8::StaticOrder, true, true>(lds, g, So, E);
            }
            xcd_barrier(bar);
            {
                CArgs* A = kargs(); unsigned char* ws = A->ws; const int tid = ltid(), lane = tid & 63, wave = __builtin_amdgcn_readfirstlane(tid >> 6); (void)lane; (void)wave;
                const int S = (sb == 0) ? 8192 : 2048;
                const bf16_t* UE = WSP(bf16_t, WS_U); bf16_t* ACT = WSP(bf16_t, WS_ACT);
                const float* cw = A->in[14] + (size_t)l * 3 * NUP; const float* cb = A->in[15] + (size_t)l * NUP;
                constexpr int NCG = DFF / 8, NITEM = (NT_SB / 256) * 2 * NCG;
#pragma unroll 1
                for (int it = bx * 512 + tid; it < NITEM; it += G * 512) {
                    const int cgp = it % NCG, pe = it / NCG, p = pe >> 1, eg = pe & 1, v0 = cgp * 8;
                    const int t = p * 256 + (eg ? 255 : 0);
                    const int ucol = 256 * (v0 >> 7) + (v0 & 127);
                    const u32x4 zero = {0u, 0u, 0u, 0u};
                    u32x4 rw[3][2];
                    const bf16_t* r0; const bf16_t* r1; const bf16_t* r2; bool hp, hn;
                    if (eg == 0) { hp = (t & (S - 1)) != 0; hn = true; r0 = UE + ((size_t)(p - 1) * 4 + 3) * NUP; r1 = UE + ((size_t)p * 4 + 0) * NUP; r2 = UE + ((size_t)p * 4 + 1) * NUP; }
                    else { hp = true; hn = ((t + 1) & (S - 1)) != 0; r0 = UE + ((size_t)p * 4 + 2) * NUP; r1 = UE + ((size_t)p * 4 + 3) * NUP; r2 = UE + ((size_t)(p + 1) * 4 + 0) * NUP; }
#pragma unroll
                    for (int pp = 0; pp < 2; ++pp) {
                        rw[0][pp] = hp ? *(const u32x4*)(r0 + ucol + pp * 128) : zero;
                        rw[1][pp] = *(const u32x4*)(r1 + ucol + pp * 128);
                        rw[2][pp] = hn ? *(const u32x4*)(r2 + ucol + pp * 128) : zero;
                    }
                    float r[2][8];
#pragma unroll
                    for (int pp = 0; pp < 2; ++pp) {
                        float wv[3][8], bv[8];
#pragma unroll
                        for (int k = 0; k < 3; ++k) { const f32x4 x0 = *(const f32x4*)(cw + k * NUP + pp * DFF + v0), x1 = *(const f32x4*)(cw + k * NUP + pp * DFF + v0 + 4);
#pragma unroll
                            for (int e = 0; e < 4; ++e) { wv[k][e] = x0[e]; wv[k][4 + e] = x1[e]; } }
                        const f32x4 y0 = *(const f32x4*)(cb + pp * DFF + v0), y1 = *(const f32x4*)(cb + pp * DFF + v0 + 4);
#pragma unroll
                        for (int e = 0; e < 4; ++e) { bv[e] = y0[e]; bv[4 + e] = y1[e]; }
#pragma unroll
                        for (int e2 = 0; e2 < 4; ++e2) {
                            const float a0 = __uint_as_float(rw[0][pp][e2] << 16), a1 = __uint_as_float(rw[0][pp][e2] & 0xffff0000u);
                            const float b0 = __uint_as_float(rw[1][pp][e2] << 16), b1 = __uint_as_float(rw[1][pp][e2] & 0xffff0000u);
                            const float c0 = __uint_as_float(rw[2][pp][e2] << 16), c1 = __uint_as_float(rw[2][pp][e2] & 0xffff0000u);
                            r[pp][2 * e2] = a0 * wv[0][2 * e2] + b0 * wv[1][2 * e2] + c0 * wv[2][2 * e2] + bv[2 * e2];
                            r[pp][2 * e2 + 1] = a1 * wv[0][2 * e2 + 1] + b1 * wv[1][2 * e2 + 1] + c1 * wv[2][2 * e2 + 1] + bv[2 * e2 + 1];
                        }
                    }
                    u32x4 o;
#pragma unroll
                    for (int e2 = 0; e2 < 4; ++e2) {
                        const pg8::f32x2 gl = pg8::gelu_pk((pg8::f32x2){r[1][2 * e2], r[1][2 * e2 + 1]});
                        o[e2] = cvt_pk_bf16(gl.x * r[0][2 * e2], gl.y * r[0][2 * e2 + 1]);
                    }
                    *(u32x4*)(ACT + (size_t)t * DFF + v0) = o;
                }
            }
            xcd_barrier(bar);
            {
                CArgs* A = kargs(); unsigned char* ws = A->ws; const int tid = ltid(), lane = tid & 63, wave = __builtin_amdgcn_readfirstlane(tid >> 6); (void)lane; (void)wave;
                float* xout = A->out + (size_t)sb * NT_SB * DM;
                pg8::Gemm g{WSP(bf16_t, WS_ACT), WSP(bf16_t, WS_WDN) + (size_t)l * DM * DFF, NT_SB, DM, DFF, DFF}; pg8::StaticOrder So; So.init(NT_SB, DM, G, bx);
                if (l == 0) { pg8::EpiResid<false> E{WSP(bf16_t, WS_XB), nullptr, WSP(float, WS_SS)}; pg8::gemm_phase<pg8::EpiResid<false>, pg8::StaticOrder, true, true>(lds, g, So, E); }
                else { pg8::EpiResid<true> E{WSP(bf16_t, WS_XB), xout, nullptr}; pg8::gemm_phase<pg8::EpiResid<true>, pg8::StaticOrder, true, true>(lds, g, So, E); }
            }
            xcd_barrier(bar);
        }
    }
}

extern "C" void kernel_launch(void* const* d_in, const int* in_sizes, int n_in, void* d_out, int out_size, void* d_ws, size_t ws_size, hipStream_t stream) {
    static int grid = 0;
    if (grid == 0) {
        if (n_in != 17 || ws_size < WS_END) { fprintf(stderr, "kernel_launch: unexpected n_in %d / ws_size %zu\n", n_in, ws_size); grid = -1; return; }
        int dev = 0, cus = 0, per_cu = 0;
        hipGetDevice(&dev); hipDeviceGetAttribute(&cus, hipDeviceAttributeMultiprocessorCount, dev);
        if (hipFuncSetAttribute((const void*)fwd_megakernel, hipFuncAttributeMaxDynamicSharedMemorySize, LDS_BYTES) != hipSuccess) { fprintf(stderr, "kernel_launch: hipFuncSetAttribute failed\n"); grid = -1; return; }
        if (hipOccupancyMaxActiveBlocksPerMultiprocessor(&per_cu, (const void*)fwd_megakernel, 512, LDS_BYTES) != hipSuccess || per_cu < 1) { fprintf(stderr, "kernel_launch: occupancy query says %d\n", per_cu); per_cu = 1; }
        (void)hipGetLastError();
        grid = cus;
    }
    if (grid < 0) return;
    if (hipMemsetAsync((char*)d_ws + WS_BAR, 0, 16384, stream) != hipSuccess) { fprintf(stderr, "kernel_launch: memset of the barrier words failed\n"); return; }
    Args a{};
    for (int i = 0; i < 17; ++i) a.in[i] = (const float*)d_in[i];
    a.out = (float*)d_out; a.ws = (unsigned char*)d_ws;
    void* args[] = {&a};
    hipError_t e = hipLaunchCooperativeKernel((const void*)fwd_megakernel, dim3(grid), dim3(512), args, LDS_BYTES, stream);
    if (e != hipSuccess) fprintf(stderr, "cooperative launch failed: %s (grid %d)\n", hipGetErrorString(e), grid);
}
```
